# Optimizing an MI355X kernel written in HIP

```python
import jax, jax.numpy as jnp
from jax import lax
import numpy as np

D_MODEL = 1024
BATCH = 2
SEQ = 8192
DEPTH = 4

HEAD_DIM = 64
ATT_Q_HEADS = 6
ATT_KV_HEADS = 2
ATT_GROUP = ATT_Q_HEADS // ATT_KV_HEADS
RET_HEADS = 6
POOL_WIDTH = D_MODEL - (ATT_Q_HEADS + RET_HEADS) * HEAD_DIM
POOL_WINDOWS = (2, 4, 8, 16)
POOL_GROUPS = len(POOL_WINDOWS)
POOL_GROUP_WIDTH = POOL_WIDTH // POOL_GROUPS
WINDOW = 128
BLOCK = 128
RET_CHUNK = 128
N_BUCKETS = 32
MAX_DISTANCE = 128
D_FF = 4 * D_MODEL
RMS_EPS = 1e-6
ROPE_BASE = 10000.0
NEG_INF = -1e30

ATT_Q_W = ATT_Q_HEADS * HEAD_DIM
ATT_KV_W = ATT_KV_HEADS * HEAD_DIM
RET_W = RET_HEADS * HEAD_DIM
IN_SIZES = (ATT_Q_W, ATT_KV_W, ATT_KV_W, RET_W, RET_W, RET_W, RET_W, POOL_WIDTH)
IN_WIDTH = sum(IN_SIZES)
SPLIT_POINTS = tuple(int(v) for v in np.cumsum(IN_SIZES)[:-1])
MIX_WIDTH = ATT_Q_W + RET_W + POOL_WIDTH

kernel_name = "hybrid_swa_retention_pool_block"


def rms_norm(x, g):
    xf = x.astype(jnp.float32)
    y = xf * lax.rsqrt(jnp.mean(xf * xf, axis=-1, keepdims=True) + RMS_EPS)
    return (y * g.astype(jnp.float32)).astype(x.dtype)


def t5_bucket(dist):
    max_exact = N_BUCKETS // 2
    n = np.maximum(dist, 0)
    large = max_exact + (np.log(np.maximum(n, 1) / max_exact)
                         / np.log(MAX_DISTANCE / max_exact)
                         * (N_BUCKETS - max_exact)).astype(np.int64)
    large = np.minimum(large, N_BUCKETS - 1)
    return np.where(n < max_exact, n, large).astype(np.int32)


def sliding_window_attention(q, k, v, sinks, rel_bias):
    B, S = q.shape[0], q.shape[1]
    N = S // BLOCK
    qb = q.reshape(B, N, BLOCK, ATT_KV_HEADS, ATT_GROUP, HEAD_DIM)
    kb = k.reshape(B, N, BLOCK, ATT_KV_HEADS, HEAD_DIM)
    vb = v.reshape(B, N, BLOCK, ATT_KV_HEADS, HEAD_DIM)

    def with_prev(t):
        prev = jnp.pad(t, ((0, 0), (1, 0), (0, 0), (0, 0), (0, 0)))[:, :-1]
        return jnp.concatenate([prev, t], axis=2)

    kk, vv = with_prev(kb), with_prev(vb)

    i = np.arange(BLOCK)[:, None]
    j = np.arange(2 * BLOCK)[None, :]
    dist = BLOCK + i - j
    band = (dist >= 0) & (dist < WINDOW)
    in_cur = j >= BLOCK
    blk = jnp.arange(N)[:, None, None]
    valid = jnp.asarray(band)[None] & ((blk > 0) | jnp.asarray(in_cur)[None])

    bias = rel_bias.astype(jnp.float32)[t5_bucket(dist)]
    bias = jnp.transpose(bias, (2, 0, 1)).reshape(ATT_KV_HEADS, ATT_GROUP, BLOCK, 2 * BLOCK)

    scores = jnp.einsum('bnihgd,bnjhd->bnhgij', qb, kk).astype(jnp.float32)
    scores = scores * (HEAD_DIM ** -0.5) + bias
    scores = jnp.where(valid[None, :, None, None], scores, NEG_INF)

    sink = sinks.astype(jnp.float32).reshape(ATT_KV_HEADS, ATT_GROUP)[None, None, :, :, None]
    m = jnp.maximum(scores.max(axis=-1), sink)
    p = jnp.exp(scores - m[..., None])
    denom = p.sum(axis=-1) + jnp.exp(sink - m)
    o = jnp.einsum('bnhgij,bnjhd->bnihgd', p, vv.astype(jnp.float32))
    o = o / jnp.transpose(denom, (0, 1, 4, 2, 3))[..., None]
    return o.reshape(B, S, ATT_Q_W).astype(q.dtype)


def rotary(x, pos):
    inv = 1.0 / (ROPE_BASE ** jnp.linspace(0.0, 1.0, HEAD_DIM // 2, dtype=jnp.float32))
    ang = pos.astype(jnp.float32)[:, None] * inv[None, :]
    cos = jnp.cos(ang)[None, :, None, :]
    sin = jnp.sin(ang)[None, :, None, :]
    xf = x.astype(jnp.float32).reshape(x.shape[:-1] + (HEAD_DIM // 2, 2))
    x1, x2 = xf[..., 0], xf[..., 1]
    return jnp.stack([x1 * cos - x2 * sin, x1 * sin + x2 * cos], axis=-1).reshape(x.shape)


def retention(q, k, v, g):
    B, S = q.shape[0], q.shape[1]
    C = RET_CHUNK
    N = S // C
    H, d = RET_HEADS, HEAD_DIM
    pos = jnp.arange(S)
    qf = rotary(q, pos)
    kf = rotary(k, pos) * (d ** -0.5)
    vf = v.astype(jnp.float32)

    lg = jnp.log(1.0 - 2.0 ** (-5.0 - jnp.arange(H, dtype=jnp.float32)))
    idx = jnp.arange(C, dtype=jnp.float32)
    diff = idx[:, None] - idx[None, :]
    dmask = jnp.where(diff >= 0, jnp.exp(lg[:, None, None] * jnp.maximum(diff, 0.0)), 0.0)

    qc = qf.reshape(B, N, C, H, d)
    kc = kf.reshape(B, N, C, H, d)
    vc = vf.reshape(B, N, C, H, d)

    inner = jnp.einsum('bnihd,bnjhd->bnhij', qc, kc) * dmask
    inner = jnp.einsum('bnhij,bnjhe->bnihe', inner, vc)

    zeta = jnp.exp(lg[:, None] * (C - 1.0 - idx)[None, :])
    U = jnp.einsum('bnjhd,bnjhe,hj->nbhde', kc, vc, zeta)
    g_chunk = jnp.exp(lg * C)[None, :, None, None]

    def step(R, u):
        return R * g_chunk + u, R

    _, R_prev = lax.scan(step, jnp.zeros((B, H, d, d), jnp.float32), U)
    xi = jnp.exp(lg[None, :] * (idx[:, None] + 1.0))
    cross = jnp.einsum('bnihd,nbhde->bnihe', qc, R_prev) * xi[None, None, :, :, None]

    o = inner + cross
    o = o * lax.rsqrt(jnp.mean(o * o, axis=-1, keepdims=True) + RMS_EPS)
    o = o.reshape(B, S, H, d)
    out = jax.nn.silu(g.astype(jnp.float32)) * o
    return out.reshape(B, S, RET_W).astype(q.dtype)


def pool_mixer(u, pool_w, pool_scale):
    B, S = u.shape[0], u.shape[1]
    uf = u.astype(jnp.float32)
    csp = jnp.pad(jnp.cumsum(uf, axis=1), ((0, 0), (1, 0), (0, 0)))
    t = jnp.arange(S)
    groups = []
    for gi, w in enumerate(POOL_WINDOWS):
        sl = slice(gi * POOL_GROUP_WIDTH, (gi + 1) * POOL_GROUP_WIDTH)
        lo = jnp.maximum(t + 1 - w, 0)
        win_sum = csp[:, 1:, sl] - csp[:, lo, sl]
        cnt = (t + 1 - lo).astype(jnp.float32)[None, :, None]
        groups.append(win_sum / cnt - uf[..., sl])
    pooled = jnp.stack(groups, axis=2)
    mixed = jnp.einsum('bsgc,gcd->bsgd', pooled, pool_w.astype(jnp.float32))
    mixed = mixed.reshape(B, S, POOL_WIDTH) * pool_scale.astype(jnp.float32)
    return mixed.astype(u.dtype)


def mixer_sublayer(x, norm_g, w_in, sinks, rel_bias, pool_w, pool_scale, w_out):
    B, S = x.shape[0], x.shape[1]
    h = rms_norm(x, norm_g)
    z = h @ w_in
    qa, ka, va, qr, kr, vr, gr, up = jnp.split(z, SPLIT_POINTS, axis=-1)
    ya = sliding_window_attention(
        qa.reshape(B, S, ATT_Q_HEADS, HEAD_DIM),
        ka.reshape(B, S, ATT_KV_HEADS, HEAD_DIM),
        va.reshape(B, S, ATT_KV_HEADS, HEAD_DIM), sinks, rel_bias)
    yr = retention(qr.reshape(B, S, RET_HEADS, HEAD_DIM),
                   kr.reshape(B, S, RET_HEADS, HEAD_DIM),
                   vr.reshape(B, S, RET_HEADS, HEAD_DIM),
                   gr.reshape(B, S, RET_HEADS, HEAD_DIM))
    yp = pool_mixer(up, pool_w, pool_scale)
    y = jnp.concatenate([ya, yr, yp], axis=-1)
    return x + y @ w_out


def mlp_sublayer(x, norm_g, w_up, w_down):
    h = rms_norm(x, norm_g)
    return x + jnp.square(jax.nn.relu(h @ w_up)) @ w_down


def setup_inputs(seed: int = 0) -> dict:
    key = jax.random.key(seed)
    ks = jax.random.split(key, 12)
    f32 = jnp.float32
    nrm = lambda k, s: jax.random.normal(k, s, dtype=f32)
    return {
        "x": nrm(ks[0], (BATCH, SEQ, D_MODEL)),
        "attn_norm_g": 1.0 + 0.1 * nrm(ks[1], (DEPTH, D_MODEL)),
        "w_in": nrm(ks[2], (DEPTH, D_MODEL, IN_WIDTH)) * D_MODEL ** -0.5,
        "attn_sinks": 0.5 * nrm(ks[3], (DEPTH, ATT_Q_HEADS)),
        "rel_bias": 0.5 * nrm(ks[4], (N_BUCKETS, ATT_Q_HEADS)),
        "pool_w": nrm(ks[5], (DEPTH, POOL_GROUPS, POOL_GROUP_WIDTH, POOL_GROUP_WIDTH)) * POOL_GROUP_WIDTH ** -0.5,
        "pool_scale": 1.0 + 0.1 * nrm(ks[6], (DEPTH, POOL_WIDTH)),
        "w_out": nrm(ks[7], (DEPTH, MIX_WIDTH, D_MODEL)) * MIX_WIDTH ** -0.5,
        "mlp_norm_g": 1.0 + 0.1 * nrm(ks[8], (DEPTH, D_MODEL)),
        "w_up": nrm(ks[9], (DEPTH, D_MODEL, D_FF)) * D_MODEL ** -0.5,
        "w_down": nrm(ks[10], (DEPTH, D_FF, D_MODEL)) * D_FF ** -0.5,
        "final_norm_g": 1.0 + 0.1 * nrm(ks[11], (D_MODEL,)),
    }


def reference(x, attn_norm_g, w_in, attn_sinks, rel_bias, pool_w, pool_scale, w_out,
              mlp_norm_g, w_up, w_down, final_norm_g):
    for layer in range(DEPTH):
        x = mixer_sublayer(x, attn_norm_g[layer], w_in[layer], attn_sinks[layer], rel_bias,
                           pool_w[layer], pool_scale[layer], w_out[layer])
        x = mlp_sublayer(x, mlp_norm_g[layer], w_up[layer], w_down[layer])
    return rms_norm(x, final_norm_g)
```

```cpp
#include <hip/hip_runtime.h>
#include <cstdio>
#include <cstdint>
namespace pg8 {
#define PG8_LAS __attribute__((address_space(3)))
typedef unsigned short bf16_t;
typedef short bf16x8 __attribute__((ext_vector_type(8)));
typedef float f32x4 __attribute__((ext_vector_type(4)));
typedef unsigned u32x4 __attribute__((ext_vector_type(4)));
constexpr int BM = 256, BK = 64, HALF = 128, HTB = HALF * BK * 2  , STAGE_BYTES = 8 * HTB, NXCD = 8, WGM = 8;

__host__ __device__ __forceinline__ int lds_byte(int r, int c) { const int st = (r >> 4) * 2 + (c >> 5), rr = r & 15, cc = c & 31, ob = rr * 64 + cc * 2; return st * 1024 + (ob ^ (((ob >> 9) & 1) << 5)); }
__host__ __device__ __forceinline__ void stage_rc(int b, int& R, int& C) { const int st = b / 1024, sb = b % 1024, swz = sb ^ (((sb >> 9) & 1) << 5); R = (st >> 1) * 16 + swz / 64; C = (st & 1) * 32 + (swz % 64) / 2; }
__host__ __device__ __forceinline__ int perm32(int rho) { const int n = rho >> 4, i = rho & 15; return 8 * (i >> 2) + 4 * n + (i & 3); }

struct Unit { int pm, pn; };
struct Gemm { const bf16_t* A; const bf16_t* Bt; int M, N, K; };

struct StaticOrder {
    int nM, nN, nwg, G, c;
    __host__ __device__ void init(int M, int N, int G_, int c_) { nM = M / BM; nN = N / BM; nwg = nM * nN; G = G_; c = c_; }
    __host__ __device__ bool next(int i, Unit& u) const {
        const long L = (long)i * G + c; if (L >= nwg) return false;
        int wgid = (int)L; { const int q = nwg / NXCD, r = nwg % NXCD, xcd = wgid % NXCD, off = wgid / NXCD; wgid = (xcd < r ? xcd * (q + 1) : r * (q + 1) + (xcd - r) * q) + off; }
        const int nig = WGM * nN, gid = wgid / nig, fm = gid * WGM, gsz = (nM - fm) < WGM ? (nM - fm) : WGM;
        u.pm = fm + ((wgid % nig) % gsz); u.pn = (wgid % nig) / gsz; return true;
    }
    __device__ __forceinline__ void a_ready(const Unit&) const {}
    __device__ __forceinline__ void done(const Unit&) const {}
};

__device__ __forceinline__ unsigned cvt_pk_bf16(float lo, float hi) { unsigned r; asm volatile("v_cvt_pk_bf16_f32 %0, %1, %2" : "=v"(r) : "v"(lo), "v"(hi)); return r; }
typedef unsigned u32x2 __attribute__((ext_vector_type(2)));

__device__ __forceinline__ float row_rstd(const float* ssq, int row) {
    const f32x4* p = (const f32x4*)(ssq + (size_t)row * 16);
    const f32x4 a = p[0], b = p[1], c = p[2], d = p[3];
    const float s = ((a[0] + a[1]) + (a[2] + a[3])) + ((b[0] + b[1]) + (b[2] + b[3])) + ((c[0] + c[1]) + (c[2] + c[3])) + ((d[0] + d[1]) + (d[2] + d[3]));
    return __builtin_amdgcn_rsqf(s * (1.0f / 1024.0f) + 1e-6f);
}

struct EpiIn {
    static constexpr bool PERM = true, AFTER_DRAIN = false;
    bf16_t* Z; int ldz; const float* ssq; const float* rope;
    __device__ __forceinline__ void operator()(const f32x4 (&acc)[2][2][4][2], const Unit& u, int wr, int wc, int fr, int fq) const {
        const int row0 = u.pm * BM + wr * 64 + fr, col0 = u.pn * BM + wc * 32 + 8 * fq;
#pragma unroll
        for (int ai = 0; ai < 2; ++ai)
#pragma unroll
            for (int m = 0; m < 4; ++m) {
                const int row = row0 + ai * HALF + m * 16; const float rs = row_rstd(ssq, row); const int pos = row & 8191;
#pragma unroll
                for (int bj = 0; bj < 2; ++bj) {
                    const int col = col0 + bj * HALF, hf = col >> 7;
                    f32x4 v0 = acc[ai][bj][m][0] * rs, v1 = acc[ai][bj][m][1] * rs;
                    if (hf >= 5 && hf < 11) {
                        const int i0 = ((col - 640) & 63) >> 1;
                        const f32x4* rp = (const f32x4*)(rope + ((size_t)pos * 32 + i0) * 2);
                        const f32x4 c01 = rp[0], c23 = rp[1];
                        f32x4 w0, w1;
                        w0[0] = v0[0] * c01[0] - v0[1] * c01[1]; w0[1] = v0[0] * c01[1] + v0[1] * c01[0];
                        w0[2] = v0[2] * c01[2] - v0[3] * c01[3]; w0[3] = v0[2] * c01[3] + v0[3] * c01[2];
                        w1[0] = v1[0] * c23[0] - v1[1] * c23[1]; w1[1] = v1[0] * c23[1] + v1[1] * c23[0];
                        w1[2] = v1[2] * c23[2] - v1[3] * c23[3]; w1[3] = v1[2] * c23[3] + v1[3] * c23[2];
                        v0 = w0; v1 = w1;
                    }
                    u32x4 w; w.x = cvt_pk_bf16(v0[0], v0[1]); w.y = cvt_pk_bf16(v0[2], v0[3]); w.z = cvt_pk_bf16(v1[0], v1[1]); w.w = cvt_pk_bf16(v1[2], v1[3]);
                    *(u32x4*)(Z + (size_t)row * ldz + col) = w;
                }
            }
    }
};

struct EpiUp {
    static constexpr bool PERM = true, AFTER_DRAIN = false;
    bf16_t* H; int ldh; const float* ssq;
    __device__ __forceinline__ void operator()(const f32x4 (&acc)[2][2][4][2], const Unit& u, int wr, int wc, int fr, int fq) const {
        const int row0 = u.pm * BM + wr * 64 + fr, col0 = u.pn * BM + wc * 32 + 8 * fq;
#pragma unroll
        for (int ai = 0; ai < 2; ++ai)
#pragma unroll
            for (int m = 0; m < 4; ++m) {
                const int row = row0 + ai * HALF + m * 16; const float rs = row_rstd(ssq, row);
#pragma unroll
                for (int bj = 0; bj < 2; ++bj) {
                    f32x4 v0 = acc[ai][bj][m][0] * rs, v1 = acc[ai][bj][m][1] * rs;
#pragma unroll
                    for (int e = 0; e < 4; ++e) { const float a = fmaxf(v0[e], 0.f), b = fmaxf(v1[e], 0.f); v0[e] = a * a; v1[e] = b * b; }
                    u32x4 w; w.x = cvt_pk_bf16(v0[0], v0[1]); w.y = cvt_pk_bf16(v0[2], v0[3]); w.z = cvt_pk_bf16(v1[0], v1[1]); w.w = cvt_pk_bf16(v1[2], v1[3]);
                    *(u32x4*)(H + (size_t)row * ldh + col0 + bj * HALF) = w;
                }
            }
    }
};

struct EpiRes {
    static constexpr bool PERM = false, AFTER_DRAIN = false;
    const float* base; float* out; bf16_t* xb; float* ssq;
    __device__ __forceinline__ void operator()(const f32x4 (&acc)[2][2][4][2], const Unit& u, int wr, int wc, int fr, int fq) const {
        const int row0 = u.pm * BM + wr * 64 + fr, col0 = u.pn * BM + wc * 32 + 4 * fq;
#pragma unroll
        for (int ai = 0; ai < 2; ++ai)
#pragma unroll
            for (int m = 0; m < 4; ++m) {
                const int row = row0 + ai * HALF + m * 16; const size_t off = (size_t)row * 1024 + col0; float s = 0.f;
#pragma unroll
                for (int bj = 0; bj < 2; ++bj)
#pragma unroll
                    for (int n = 0; n < 2; ++n) {
                        const f32x4 b = *(const f32x4*)(base + off + bj * HALF + n * 16); const f32x4 x = b + acc[ai][bj][m][n];
                        *(f32x4*)(out + off + bj * HALF + n * 16) = x;
                        u32x2 w; w.x = cvt_pk_bf16(x[0], x[1]); w.y = cvt_pk_bf16(x[2], x[3]);
                        *(u32x2*)(xb + off + bj * HALF + n * 16) = w;
                        s += (x[0] * x[0] + x[1] * x[1]) + (x[2] * x[2] + x[3] * x[3]);
                    }
                s += __shfl_xor(s, 16); s += __shfl_xor(s, 32);
                if (fq == 0) ssq[(size_t)row * 16 + u.pn * 4 + wc] = s;
            }
    }
};

template <class Epi, class Sched, bool ALIGN_EPI = false, bool SP2 = false>
__device__ __forceinline__ void gemm_phase(PG8_LAS unsigned char* lds, const Gemm g, const Sched& S, const Epi& E) {
    int tid_ = threadIdx.x; asm volatile("" : "+v"(tid_));
    const int tid = tid_, wid = __builtin_amdgcn_readfirstlane(tid >> 6), lane = tid & 63, wr = wid >> 2, wc = wid & 3, fr = lane & 15, fq = lane >> 4;
    const int K = g.K, nt = K / BK;
    unsigned voffA[2], voffB[2];
#pragma unroll
    for (int i = 0; i < 2; ++i) { int R, C; stage_rc(tid * 16 + i * 8192, R, C); const int Rb = Epi::PERM ? ((R & ~31) + perm32(R & 31)) : R;
        voffA[i] = (unsigned)(R * K + C) * 2u; voffB[i] = (unsigned)(Rb * K + C) * 2u; }
    const size_t kstep = (size_t)(BK * 2);
    const size_t hstep = (size_t)HALF * K * 2;
    const size_t tstep = 2 * hstep;
    const unsigned ldsw = (unsigned)wid * 1024u;
    const int aoff = lds_byte(wr * 64 + fr, fq * 8), boff = lds_byte(wc * 32 + fr, fq * 8);
#define PG8_SA(b, h) (((b) * 2 + (h)) * HTB)
#define PG8_SB(b, h) ((4 + (b) * 2 + (h)) * HTB)
#define PG8_STAGE(bufoff, gbase, voff) do { _Pragma("unroll") for (int _i = 0; _i < 2; ++_i) \
        __builtin_amdgcn_global_load_lds((const unsigned*)((const char*)(gbase) + (voff)[_i]), (PG8_LAS unsigned*)(lds + (bufoff) + ldsw + _i * 8192), 16, 0, 0); } while (0)
#define PG8_LDA(dst, b, h) do { _Pragma("unroll") for (int m = 0; m < 4; ++m) _Pragma("unroll") for (int k = 0; k < 2; ++k) dst[m][k] = *(const PG8_LAS bf16x8*)(lds + PG8_SA(b, h) + aoff + m * 2048 + k * 1024); } while (0)
#define PG8_LDB(dst, b, h) do { _Pragma("unroll") for (int n = 0; n < 2; ++n) _Pragma("unroll") for (int k = 0; k < 2; ++k) dst[n][k] = *(const PG8_LAS bf16x8*)(lds + PG8_SB(b, h) + boff + n * 2048 + k * 1024); } while (0)
#define PG8_MMA(ai, bj, At, Bt) do { __builtin_amdgcn_s_setprio(1); _Pragma("unroll") for (int m = 0; m < 4; ++m) _Pragma("unroll") for (int n = 0; n < 2; ++n) _Pragma("unroll") for (int k = 0; k < 2; ++k) \
        acc[ai][bj][m][n] = __builtin_amdgcn_mfma_f32_16x16x32_bf16(Bt[n][k], At[m][k], acc[ai][bj][m][n], 0, 0, 0); __builtin_amdgcn_s_setprio(0); } while (0)
#define PG8_WAIT_V(n) asm volatile("s_waitcnt vmcnt(" #n ")" ::: "memory")
#define PG8_WAIT_L(n) asm volatile("s_waitcnt lgkmcnt(" #n ")" ::: "memory")
#define PG8_BAR __builtin_amdgcn_s_barrier()
#define PG8_SCHED __builtin_amdgcn_sched_barrier(0)
    Unit cur, nxt; int ui = 0;
    if (!S.next(0, cur)) return;
    f32x4 acc[2][2][4][2];
#pragma unroll
    for (int a = 0; a < 2; ++a)
#pragma unroll
        for (int b = 0; b < 2; ++b)
#pragma unroll
            for (int m = 0; m < 4; ++m)
#pragma unroll
                for (int n = 0; n < 2; ++n) acc[a][b][m][n] = (f32x4){0.f, 0.f, 0.f, 0.f};
    bf16x8 At[4][2], B0[2][2], B1[2][2];
    const char* cA = (const char*)g.A + (size_t)cur.pm * tstep; const char* cB = (const char*)g.Bt + (size_t)cur.pn * tstep;
    S.a_ready(cur);
    if constexpr (SP2) {
        PG8_STAGE(PG8_SB(0, 0), cB, voffB); PG8_STAGE(PG8_SB(0, 1), cB + hstep, voffB); PG8_STAGE(PG8_SA(0, 0), cA, voffA); PG8_STAGE(PG8_SA(0, 1), cA + hstep, voffA);
        if (wr == 1) PG8_BAR;
        PG8_WAIT_V(2); PG8_BAR;
        PG8_STAGE(PG8_SB(1, 0), cB + kstep, voffB); PG8_STAGE(PG8_SA(1, 0), cA + kstep, voffA); PG8_STAGE(PG8_SB(1, 1), cB + hstep + kstep, voffB);
        PG8_WAIT_V(6); PG8_BAR;
    } else {
        PG8_STAGE(PG8_SB(0, 0), cB, voffB); PG8_STAGE(PG8_SA(0, 0), cA, voffA); PG8_STAGE(PG8_SB(0, 1), cB + hstep, voffB); PG8_STAGE(PG8_SA(0, 1), cA + hstep, voffA);
        if (wr == 1) PG8_BAR;
        PG8_WAIT_V(4); PG8_BAR;
        PG8_STAGE(PG8_SB(1, 0), cB + kstep, voffB); PG8_STAGE(PG8_SA(1, 0), cA + kstep, voffA); PG8_STAGE(PG8_SB(1, 1), cB + hstep + kstep, voffB);
        PG8_WAIT_V(6); PG8_BAR;
    }
    for (;;) {
        const bool has_next = S.next(ui + 1, nxt);
        const char* nA = has_next ? (const char*)g.A + (size_t)nxt.pm * tstep : cA; const char* nB = has_next ? (const char*)g.Bt + (size_t)nxt.pn * tstep : cB;
        for (int t = 0; t < nt; t += 2) {
            const bool last = (t == nt - 2);
            const char* a1 = cA + (size_t)(t + 1) * kstep;
            const char* a2 = last ? nA : cA + (size_t)(t + 2) * kstep; const char* b2 = last ? nB : cB + (size_t)(t + 2) * kstep;
            const char* a3 = a2 + kstep; const char* b3 = b2 + kstep;
            if (last && has_next) S.a_ready(nxt);
            if constexpr (SP2) {
            PG8_LDB(B0, 0, 0); PG8_LDB(B1, 0, 1); PG8_SCHED; PG8_LDA(At, 0, 0); PG8_STAGE(PG8_SA(1, 1), a1 + hstep, voffA);
            PG8_WAIT_V(8); PG8_WAIT_L(0); PG8_BAR; PG8_MMA(0, 0, At, B0); PG8_MMA(0, 1, At, B1); PG8_BAR; PG8_SCHED;
            PG8_LDA(At, 0, 1); PG8_STAGE(PG8_SB(0, 0), b2, voffB); PG8_STAGE(PG8_SB(0, 1), b2 + hstep, voffB); PG8_STAGE(PG8_SA(0, 0), a2, voffA);
            PG8_WAIT_V(8); PG8_WAIT_L(0); PG8_BAR; PG8_MMA(1, 0, At, B0); PG8_MMA(1, 1, At, B1); PG8_BAR; PG8_SCHED;
            PG8_LDB(B0, 1, 0); PG8_LDB(B1, 1, 1); PG8_SCHED; PG8_LDA(At, 1, 0); PG8_STAGE(PG8_SA(0, 1), a2 + hstep, voffA);
            PG8_WAIT_V(8); PG8_WAIT_L(0); PG8_BAR; PG8_MMA(0, 0, At, B0); PG8_MMA(0, 1, At, B1); PG8_BAR; PG8_SCHED;
            PG8_LDA(At, 1, 1); PG8_STAGE(PG8_SB(1, 0), b3, voffB); PG8_STAGE(PG8_SB(1, 1), b3 + hstep, voffB); PG8_STAGE(PG8_SA(1, 0), a3, voffA);
            PG8_WAIT_V(8); PG8_WAIT_L(0); PG8_BAR; PG8_MMA(1, 0, At, B0); PG8_MMA(1, 1, At, B1); PG8_BAR; PG8_SCHED;
            } else {
            PG8_LDB(B0, 0, 0); PG8_SCHED; PG8_LDA(At, 0, 0); PG8_STAGE(PG8_SA(1, 1), a1 + hstep, voffA);
            PG8_WAIT_L(8); PG8_BAR; PG8_WAIT_L(0); PG8_MMA(0, 0, At, B0); PG8_BAR; PG8_SCHED;
            PG8_LDB(B1, 0, 1); PG8_STAGE(PG8_SB(0, 0), b2, voffB);
            PG8_BAR; PG8_WAIT_L(0); PG8_MMA(0, 1, At, B1); PG8_BAR;
            PG8_LDA(At, 0, 1); PG8_STAGE(PG8_SA(0, 0), a2, voffA);
            PG8_BAR; PG8_WAIT_L(0); PG8_MMA(1, 0, At, B0); PG8_BAR; PG8_SCHED;
            PG8_STAGE(PG8_SB(0, 1), b2 + hstep, voffB);
            PG8_WAIT_V(6); PG8_BAR; PG8_MMA(1, 1, At, B1); PG8_BAR;
            PG8_LDB(B0, 1, 0); PG8_SCHED; PG8_LDA(At, 1, 0); PG8_STAGE(PG8_SA(0, 1), a2 + hstep, voffA);
            PG8_WAIT_L(8); PG8_BAR; PG8_WAIT_L(0); PG8_MMA(0, 0, At, B0); PG8_BAR; PG8_SCHED;
            PG8_LDB(B1, 1, 1); PG8_STAGE(PG8_SB(1, 0), b3, voffB);
            PG8_BAR; PG8_WAIT_L(0); PG8_MMA(0, 1, At, B1); PG8_BAR;
            PG8_LDA(At, 1, 1); PG8_STAGE(PG8_SA(1, 0), a3, voffA);
            PG8_BAR; PG8_WAIT_L(0); PG8_MMA(1, 0, At, B0); PG8_BAR; PG8_SCHED;
            PG8_STAGE(PG8_SB(1, 1), b3 + hstep, voffB);
            PG8_WAIT_V(6); PG8_BAR; PG8_MMA(1, 1, At, B1); PG8_BAR;
            }
        }
        if constexpr (ALIGN_EPI) { if (wr == 0) PG8_BAR; }
        if constexpr (!Epi::AFTER_DRAIN) { E(acc, cur, wr, wc, fr, fq); S.done(cur); }
        if (!has_next) break;
#pragma unroll
        for (int a = 0; a < 2; ++a)
#pragma unroll
            for (int b = 0; b < 2; ++b)
#pragma unroll
                for (int m = 0; m < 4; ++m)
#pragma unroll
                    for (int n = 0; n < 2; ++n) acc[a][b][m][n] = (f32x4){0.f, 0.f, 0.f, 0.f};
        cur = nxt; cA = nA; cB = nB; ++ui;
        if constexpr (ALIGN_EPI) { if (wr == 1) PG8_BAR; }
    }
    PG8_WAIT_V(0);
    if constexpr (!ALIGN_EPI) { if (wr == 0) PG8_BAR; }
    PG8_BAR;
    if constexpr (Epi::AFTER_DRAIN) { E.fused(acc, cur, wr, wc, fr, fq, lds, wid, lane); S.done(cur); }
#undef PG8_SA
#undef PG8_SB
#undef PG8_STAGE
#undef PG8_LDA
#undef PG8_LDB
#undef PG8_MMA
#undef PG8_WAIT_V
#undef PG8_WAIT_L
#undef PG8_BAR
#undef PG8_SCHED
}
}

constexpr int NWAVES = 8, NTHR = NWAVES * 64;
constexpr int SEQ = 8192, DM = 1024, MROWS = 2 * SEQ, NIN = 2432, ZP = 2560, FF = 4096, DEPTH = 4;
constexpr int C_QA = 0, C_KA = 384, C_VA = 512, C_QR = 640, C_KR = 1024, C_VR = 1408, C_GR = 1792, C_UP = 2176;
constexpr int Y_A = 0, Y_R = 384, Y_P = 768;
constexpr int NPHASE = 2 + 7 * DEPTH;

constexpr size_t MiB = 1u << 20;
constexpr size_t WS_CTL = 0, CTL_ZERO_BYTES = 64 * 1024;
constexpr size_t WS_SSQ = 1 * MiB;
constexpr size_t WS_W = 2 * MiB;
constexpr size_t W_LAYER = 23 * MiB, W_IN = 0, W_OUT = 5 * MiB, W_UP = 7 * MiB, W_DN = 15 * MiB;
constexpr size_t WS_XB = 94 * MiB;
constexpr size_t WS_H = 126 * MiB;
constexpr size_t WS_Z = 126 * MiB;
constexpr size_t WS_Y = 206 * MiB;
constexpr size_t WS_U = 238 * MiB;
constexpr size_t WS_ROPE = 254 * MiB;
constexpr size_t WS_END = 256 * MiB;
static_assert(WS_W + DEPTH * W_LAYER <= WS_XB && WS_Z + (size_t)MROWS * ZP * 2 <= WS_Y && WS_Y + (size_t)MROWS * DM * 2 <= WS_U && WS_U + 12 * MiB <= WS_H + 128 * MiB && WS_H + 128 * MiB <= WS_ROPE, "d_ws map");
constexpr int CW_BAR = 4096;

constexpr int RING_OFF = 0, RING_BYTES = 131072;
constexpr int LDSCTL_OFF = RING_BYTES, MISC_OFF = LDSCTL_OFF + 320;
constexpr int LDS_BYTES = 147456;

#define GAS __attribute__((address_space(1)))
#define LAS __attribute__((address_space(3)))
typedef unsigned short bf16;
typedef unsigned v4u __attribute__((ext_vector_type(4)));
typedef unsigned v2u __attribute__((ext_vector_type(2)));
typedef float f32x4 __attribute__((ext_vector_type(4)));
typedef GAS unsigned gu32;
#define LDS_WAIT() asm volatile("s_waitcnt lgkmcnt(0)" ::: "memory")
__device__ __forceinline__ unsigned f2bf(float f) { unsigned u = __builtin_bit_cast(unsigned, f); return (u + 0x7fffu + ((u >> 16) & 1u)) >> 16; }
__device__ __forceinline__ unsigned pk2(float lo, float hi) { return f2bf(lo) | (f2bf(hi) << 16); }
__device__ __forceinline__ float bflo(unsigned w) { return __uint_as_float(w << 16); }
__device__ __forceinline__ float bfhi(unsigned w) { return __uint_as_float(w & 0xffff0000u); }
__device__ __forceinline__ float bf1(const bf16* p) { return __uint_as_float((unsigned)(*p) << 16); }
__device__ __forceinline__ void ld8(const bf16* p, float (&o)[8]) { const v4u w = *(const v4u*)p; o[0] = bflo(w.x); o[1] = bfhi(w.x); o[2] = bflo(w.y); o[3] = bfhi(w.y); o[4] = bflo(w.z); o[5] = bfhi(w.z); o[6] = bflo(w.w); o[7] = bfhi(w.w); }
__device__ __forceinline__ void st8(bf16* p, const float (&o)[8]) { v4u w; w.x = pk2(o[0], o[1]); w.y = pk2(o[2], o[3]); w.z = pk2(o[4], o[5]); w.w = pk2(o[6], o[7]); *(v4u*)p = w; }
__device__ __forceinline__ float wave_sum(float v) {
#pragma unroll
    for (int o = 1; o < 64; o <<= 1) v += __shfl_xor(v, o);
    return v;
}
__device__ __constant__ unsigned char kT5[128] = {0,1,2,3,4,5,6,7,8,9,10,11,12,13,14,15,16,16,16,17,17,18,18,18,19,19,19,20,20,20,20,21,21,21,21,22,22,22,22,22,23,23,23,23,23,23,24,24,24,24,24,24,25,25,25,25,25,25,25,26,26,26,26,26,26,26,26,27,27,27,27,27,27,27,27,27,27,28,28,28,28,28,28,28,28,28,28,29,29,29,29,29,29,29,29,29,29,29,29,30,30,30,30,30,30,30,30,30,30,30,30,30,30,31,31,31,31,31,31,31,31,31,31,31,31,31,31,31};
__device__ __forceinline__ float ret_lg(int h) { return log1pf(-exp2f(-5.0f - (float)h)); }
#define XB_TMO      128
#define XB_XCNT(j)  (256  + 64 * (j))
#define XB_XSUB(j)  (1280 + 64 * (j))
#define XB_XGEN(j)  (2304 + 64 * (j))
#define XB_TOP      3328
#define XB_TOPGEN   3392
#define XCD_BAR_WORDS 3456
#define XB_SPIN_CAP (1u << 18)

__device__ __forceinline__ unsigned xb_ld(unsigned* p)              { return __hip_atomic_load(p, __ATOMIC_RELAXED, __HIP_MEMORY_SCOPE_AGENT); }
__device__ __forceinline__ unsigned xb_add(unsigned* p, unsigned v) { return __hip_atomic_fetch_add(p, v, __ATOMIC_RELAXED, __HIP_MEMORY_SCOPE_AGENT); }
__device__ __forceinline__ unsigned xb_xcc_id() { return (unsigned)__builtin_amdgcn_s_getreg((3 << 11) | 20) & 0xFu; }
#define XB_SPIN(cond, bar) do { unsigned _sp = 0; while (cond) { __builtin_amdgcn_s_sleep(1); \
    if ((++_sp & 255u) == 0u) { if (xb_ld(&(bar)[XB_TMO])) break; if (_sp > XB_SPIN_CAP) { atomicAdd(&(bar)[XB_TMO], 1u); break; } } } } while (0)

struct XcdBarrier {
    unsigned* bar; unsigned x;
    volatile LAS unsigned* st;
};

__device__ __forceinline__ XcdBarrier xcd_barrier_post(unsigned* bar, volatile LAS unsigned* st) {
    XcdBarrier b; b.bar = bar; b.x = xb_xcc_id(); b.st = st;
    if (threadIdx.x == 0) (void)xb_add(&bar[XB_XCNT(b.x)], 1u);
    return b;
}
__device__ __forceinline__ void xcd_barrier_complete(unsigned* bar, unsigned x, unsigned& nloc, unsigned& nx) {
    const unsigned G = gridDim.x * gridDim.y * gridDim.z;
    unsigned sum, cnt, mine, sp = 0u;
    for (;;) {
        sum = 0u; cnt = 0u; mine = 0u;
#pragma unroll
        for (unsigned j = 0; j < 16; ++j) { const unsigned c = xb_ld(&bar[XB_XCNT(j)]); sum += c; cnt += (c > 0u) ? 1u : 0u; mine = (j == x) ? c : mine; }
        if (sum == G) break;
        __builtin_amdgcn_s_sleep(1);
        if ((++sp & 255u) == 0u) { if (xb_ld(&bar[XB_TMO])) break; if (sp > XB_SPIN_CAP) { atomicAdd(&bar[XB_TMO], 1u); break; } }
    }
    nloc = mine > 0u ? mine : 1u; nx = cnt > 0u ? cnt : 1u;
}

__device__ __forceinline__ void xcd_barrier(const XcdBarrier& b) {
    asm volatile("s_waitcnt vmcnt(0)" ::: "memory");
    __syncthreads();
    if (threadIdx.x == 0) {
        unsigned* bar = b.bar;
        __builtin_amdgcn_s_waitcnt(0);
        unsigned nloc = b.st[0], nx = b.st[1];
        if (nloc == 0u) { xcd_barrier_complete(bar, b.x, nloc, nx); b.st[0] = nloc; b.st[1] = nx; }
        const unsigned old = xb_add(&bar[XB_XSUB(b.x)], 1u);
        const unsigned gen = old / nloc;
        if (old + 1u == (gen + 1u) * nloc) {
            __builtin_amdgcn_fence(__ATOMIC_RELEASE, "agent");
            asm volatile("s_waitcnt vmcnt(0)" ::: "memory");
            const unsigned og = xb_add(&bar[XB_TOP], 1u);
            const unsigned tg = og / nx;
            if (og + 1u == (tg + 1u) * nx) xb_add(&bar[XB_TOPGEN], 1u);
            else XB_SPIN(xb_ld(&bar[XB_TOPGEN]) == tg, bar);
            __builtin_amdgcn_fence(__ATOMIC_ACQUIRE, "agent");
            xb_add(&bar[XB_XGEN(b.x)], 1u);
            asm volatile("s_waitcnt vmcnt(0)" ::: "memory");
        } else {
            XB_SPIN(xb_ld(&bar[XB_XGEN(b.x)]) == gen, bar);
            __builtin_amdgcn_fence(__ATOMIC_ACQUIRE, "agent");
            asm volatile("s_waitcnt vmcnt(0)" ::: "memory");
        }
    }
    __syncthreads();
}

struct Args { const float* in[12]; float* out; unsigned char* ws; int ph_lo, ph_hi; };
struct Frame {
    LAS unsigned char* lds;
    int tid, lane, wave, G, bid;
    unsigned char* ws;
};
__device__ __forceinline__ Frame phase_frame(const Frame& F0) { Frame F = F0; int t = threadIdx.x; asm volatile("" : "+v"(t)); F.tid = t; F.lane = t & 63; F.wave = __builtin_amdgcn_readfirstlane(t >> 6); return F; }
#define A_X        (A.in[0])
#define A_ATTN_G   (A.in[1])
#define A_W_IN     (A.in[2])
#define A_SINKS    (A.in[3])
#define A_RELB     (A.in[4])
#define A_POOLW    (A.in[5])
#define A_POOLS    (A.in[6])
#define A_W_OUT    (A.in[7])
#define A_MLP_G    (A.in[8])
#define A_W_UP     (A.in[9])
#define A_W_DOWN   (A.in[10])
#define A_FINAL_G  (A.in[11])
#define P_SSQ  ((float*)(F.ws + WS_SSQ))
#define P_XB   ((bf16*)(F.ws + WS_XB))
#define P_Z    ((bf16*)(F.ws + WS_Z))
#define P_Y    ((bf16*)(F.ws + WS_Y))
#define P_H    ((bf16*)(F.ws + WS_H))
#define P_U    ((float*)(F.ws + WS_U))
#define P_ROPE ((float*)(F.ws + WS_ROPE))
__device__ __forceinline__ bf16* wptr(const Frame& F, int layer, size_t off) { return (bf16*)(F.ws + WS_W + (size_t)layer * W_LAYER + off); }

__device__ __forceinline__ void p0_transpose_item(const float* W, int K, int N, bf16* WT, LAS float* scr, int item, int lane, const float* gk, int colmode) {
    const int nblk = N / 32, kb = item / nblk, nb = item % nblk, k0 = 64 * kb, n0 = 32 * nb;
    const int ncol = n0 + (lane & 31);
    const float cs = (colmode && (ncol < C_KA || (ncol >= C_KR && ncol < C_VR))) ? 0.125f : 1.0f;
#pragma unroll 8
    for (int i = 0; i < 32; ++i) { const int kk = 2 * i + (lane >> 5); const float g = gk ? gk[k0 + kk] : 1.0f; scr[kk * 33 + (lane & 31)] = W[(size_t)(k0 + kk) * N + ncol] * (g * cs); }
    LDS_WAIT(); asm volatile("" ::: "memory");
    const int c = lane & 7;
#pragma unroll
    for (int j = 0; j < 4; ++j) { const int n = (lane >> 3) + 8 * j; const LAS float* s = scr + (8 * c) * 33 + n;
        v4u o; o.x = pk2(s[0 * 33], s[1 * 33]); o.y = pk2(s[2 * 33], s[3 * 33]); o.z = pk2(s[4 * 33], s[5 * 33]); o.w = pk2(s[6 * 33], s[7 * 33]);
        *(GAS v4u*)(WT + (size_t)(n0 + n) * K + k0 + 8 * c) = o; }
    LDS_WAIT(); asm volatile("" ::: "memory");
}
__device__ __forceinline__ void p0_prologue(const Frame& F0, const Args& A) {
    const Frame F = phase_frame(F0);
    LAS float* scr = (LAS float*)(F.lds + RING_OFF + F.wave * 16384);
    const int gw = F.bid * NWAVES + F.wave, NGW = F.G * NWAVES;
    constexpr int I_IN = (DM / 64) * (NIN / 32), I_OUT = (DM / 64) * (DM / 32), I_UP = (DM / 64) * (FF / 32), I_DN = (FF / 64) * (DM / 32), I_L = I_IN + I_OUT + I_UP + I_DN;
    for (int it = gw; it < DEPTH * I_L; it += NGW) {
        const int l = it / I_L; int r = it % I_L;
        if (r < I_IN) { p0_transpose_item(A_W_IN + (size_t)l * DM * NIN, DM, NIN, wptr(F, l, W_IN), scr, r, F.lane, A_ATTN_G + l * DM, 1); continue; } r -= I_IN;
        if (r < I_OUT) { p0_transpose_item(A_W_OUT + (size_t)l * DM * DM, DM, DM, wptr(F, l, W_OUT), scr, r, F.lane, nullptr, 0); continue; } r -= I_OUT;
        if (r < I_UP) { p0_transpose_item(A_W_UP + (size_t)l * DM * FF, DM, FF, wptr(F, l, W_UP), scr, r, F.lane, A_MLP_G + l * DM, 0); continue; } r -= I_UP;
        p0_transpose_item(A_W_DOWN + (size_t)l * FF * DM, FF, DM, wptr(F, l, W_DN), scr, r, F.lane, nullptr, 0);
    }
    for (int it = gw; it < DEPTH * (ZP - NIN); it += NGW) { const int l = it / (ZP - NIN), n = NIN + it % (ZP - NIN);
        GAS v4u* o = (GAS v4u*)(wptr(F, l, W_IN) + (size_t)n * DM) + F.lane; o[0] = (v4u){0u, 0u, 0u, 0u}; o[64] = (v4u){0u, 0u, 0u, 0u}; }
    for (int it = (F.bid * NTHR + F.tid); it < SEQ * 32; it += F.G * NTHR) { const int pos = it >> 5, i = it & 31;
        const float lin = (float)i * (1.0f / 31.0f); const float inv = 1.0f / powf(10000.0f, lin); const float ang = (float)pos * inv;
        const double a = (double)ang; const double k = rint(a * 0.15915494309189535); const float r = (float)(a - k * 6.283185307179586);
        P_ROPE[2 * it] = cosf(r); P_ROPE[2 * it + 1] = sinf(r); }
    for (int m = gw; m < MROWS; m += NGW) {
        const GAS f32x4* xr = (const GAS f32x4*)(A_X + (size_t)m * DM) + F.lane; f32x4 v[4]; float s = 0.f;
#pragma unroll
        for (int j = 0; j < 4; ++j) { v[j] = xr[64 * j]; s += (v[j].x * v[j].x + v[j].y * v[j].y) + (v[j].z * v[j].z + v[j].w * v[j].w); }
        s = wave_sum(s);
        GAS v2u* o8 = (GAS v2u*)(P_XB + (size_t)m * DM) + F.lane;
#pragma unroll
        for (int j = 0; j < 4; ++j) { v2u w; w.x = pk2(v[j].x, v[j].y); w.y = pk2(v[j].z, v[j].w); o8[64 * j] = w; }
        if (F.lane < 16) P_SSQ[(size_t)m * 16 + F.lane] = F.lane == 0 ? s : 0.f;
    }
}

__device__ __forceinline__ void mix_attn_simple(const Frame& F0, const Args& A, int layer) {
    const Frame F = phase_frame(F0);
    for (int it = F.bid * NTHR + F.tid; it < 6 * MROWS; it += F.G * NTHR) {
        const int hq = it / MROWS, row = it % MROWS, t = row & (SEQ - 1), hk = hq / 3;
        float q[64], acc[64];
#pragma unroll
        for (int c = 0; c < 8; ++c) { float tmp[8]; ld8(P_Z + (size_t)row * ZP + C_QA + hq * 64 + c * 8, tmp);
#pragma unroll
            for (int e = 0; e < 8; ++e) { q[c * 8 + e] = tmp[e]; acc[c * 8 + e] = 0.f; } }
        float m = -1e30f, l = 0.f;
        const int jlo = t - 127 > 0 ? t - 127 : 0;
        for (int tk = jlo; tk <= t; ++tk) {
            const bf16* kr = P_Z + (size_t)(row - t + tk) * ZP + C_KA + hk * 64; const bf16* vr = P_Z + (size_t)(row - t + tk) * ZP + C_VA + hk * 64;
            float s = 0.f;
#pragma unroll
            for (int c = 0; c < 8; ++c) { float tmp[8]; ld8(kr + c * 8, tmp);
#pragma unroll
                for (int e = 0; e < 8; ++e) s += q[c * 8 + e] * tmp[e]; }
            s += A_RELB[(int)kT5[t - tk] * 6 + hq];
            const float mn = fmaxf(m, s), cf = __expf(m - mn), p = __expf(s - mn);
            l = l * cf + p; m = mn;
#pragma unroll
            for (int c = 0; c < 8; ++c) { float tmp[8]; ld8(vr + c * 8, tmp);
#pragma unroll
                for (int e = 0; e < 8; ++e) acc[c * 8 + e] = acc[c * 8 + e] * cf + p * tmp[e]; }
        }
        const float sk = A_SINKS[layer * 6 + hq], mf = fmaxf(m, sk), cf = __expf(m - mf), den = l * cf + __expf(sk - mf), sc = cf / den;
#pragma unroll
        for (int c = 0; c < 8; ++c) { float tmp[8];
#pragma unroll
            for (int e = 0; e < 8; ++e) tmp[e] = acc[c * 8 + e] * sc;
            st8(P_Y + (size_t)row * DM + Y_A + hq * 64 + c * 8, tmp); }
    }
}
__device__ __forceinline__ void mix_pool_simple(const Frame& F0, const Args& A, int layer) {
    const Frame F = phase_frame(F0);
    LAS float* P = (LAS float*)(F.lds + RING_OFF);
    for (int u = F.bid; u < MROWS / 8; u += F.G) {
        __syncthreads();
        for (int e = F.tid; e < 2048; e += NTHR) { const int r = e >> 8, c = e & 255, row = u * 8 + r, t = row & (SEQ - 1), g = c >> 6, w = 2 << g;
            const int lo = t + 1 - w > 0 ? t + 1 - w : 0; float s = 0.f;
            for (int sp = lo; sp <= t; ++sp) s += bf1(P_Z + (size_t)(row - t + sp) * ZP + C_UP + c);
            P[e] = s / (float)(t + 1 - lo) - bf1(P_Z + (size_t)row * ZP + C_UP + c); }
        __syncthreads();
        for (int e = F.tid; e < 2048; e += NTHR) { const int r = e >> 8, c = e & 255, row = u * 8 + r, g = c >> 6, d = c & 63;
            const float* pw = A_POOLW + ((size_t)(layer * 4 + g) * 64) * 64 + d; float a = 0.f;
            for (int cc = 0; cc < 64; ++cc) a += P[r * 256 + g * 64 + cc] * pw[cc * 64];
            P_Y[(size_t)row * DM + Y_P + c] = (bf16)f2bf(a * A_POOLS[layer * 256 + c]); }
    }
}
__device__ __forceinline__ void mix_retU_simple(const Frame& F0, const Args& A) {
    const Frame F = phase_frame(F0);
    const int d = F.tid >> 3, e0 = (F.tid & 7) * 8;
    for (int u = F.bid; u < 12 * 64; u += F.G) {
        const int bh = u >> 6, n = u & 63, b = bh / 6, h = bh % 6, row0 = b * SEQ + n * 128; const float lg = ret_lg(h);
        float acc[8];
#pragma unroll
        for (int e = 0; e < 8; ++e) acc[e] = 0.f;
        for (int j = 0; j < 128; ++j) { const float kd = bf1(P_Z + (size_t)(row0 + j) * ZP + C_KR + h * 64 + d) * __expf(lg * (float)(127 - j));
            float v[8]; ld8(P_Z + (size_t)(row0 + j) * ZP + C_VR + h * 64 + e0, v);
#pragma unroll
            for (int e = 0; e < 8; ++e) acc[e] += kd * v[e]; }
        float* o = P_U + (size_t)u * 4096 + d * 64 + e0;
        *(f32x4*)o = (f32x4){acc[0], acc[1], acc[2], acc[3]}; *(f32x4*)(o + 4) = (f32x4){acc[4], acc[5], acc[6], acc[7]};
    }
}
__device__ __forceinline__ void mix_scan_simple(const Frame& F0, const Args& A) {
    const Frame F = phase_frame(F0);
    for (int it = F.bid * NTHR + F.tid; it < 12 * 4096; it += F.G * NTHR) {
        const int bh = it >> 12, de = it & 4095, h = bh % 6; const float gch = __expf(ret_lg(h) * 128.0f);
        float* p = P_U + (size_t)bh * 64 * 4096 + de; float R = 0.f;
        for (int n = 0; n < 64; ++n) { const float u = p[(size_t)n * 4096]; p[(size_t)n * 4096] = R; R = R * gch + u; }
    }
}
__device__ __forceinline__ void mix_retout_simple(const Frame& F0, const Args& A) {
    const Frame F = phase_frame(F0);
    for (int it = F.bid * NTHR + F.tid; it < 6 * MROWS; it += F.G * NTHR) {
        const int h = it / MROWS, row = it % MROWS, t = row & (SEQ - 1), b = row >> 13, n = t >> 7, i = t & 127; const float lg = ret_lg(h);
        const bf16* zq = P_Z + (size_t)row * ZP + C_QR + h * 64;
        const float* R = P_U + ((size_t)(b * 6 + h) * 64 + n) * 4096;
        float acc[64];
#pragma unroll
        for (int e = 0; e < 64; ++e) acc[e] = 0.f;
        for (int d = 0; d < 64; ++d) { const float qd = bf1(zq + d); const f32x4* Rr = (const f32x4*)(R + d * 64);
#pragma unroll
            for (int e4 = 0; e4 < 16; ++e4) { const f32x4 r = Rr[e4]; acc[4 * e4] += qd * r.x; acc[4 * e4 + 1] += qd * r.y; acc[4 * e4 + 2] += qd * r.z; acc[4 * e4 + 3] += qd * r.w; } }
        const float xi = __expf(lg * (float)(i + 1));
#pragma unroll
        for (int e = 0; e < 64; ++e) acc[e] *= xi;
        float q[64];
#pragma unroll
        for (int c = 0; c < 8; ++c) { float tmp[8]; ld8(zq + c * 8, tmp);
#pragma unroll
            for (int e = 0; e < 8; ++e) q[c * 8 + e] = tmp[e]; }
        for (int j = 0; j <= i; ++j) {
            const bf16* kr = P_Z + (size_t)(row - i + j) * ZP + C_KR + h * 64; const bf16* vr = P_Z + (size_t)(row - i + j) * ZP + C_VR + h * 64;
            float s = 0.f;
#pragma unroll
            for (int c = 0; c < 8; ++c) { float tmp[8]; ld8(kr + c * 8, tmp);
#pragma unroll
                for (int e = 0; e < 8; ++e) s += q[c * 8 + e] * tmp[e]; }
            s *= __expf(lg * (float)(i - j));
#pragma unroll
            for (int c = 0; c < 8; ++c) { float tmp[8]; ld8(vr + c * 8, tmp);
#pragma unroll
                for (int e = 0; e < 8; ++e) acc[c * 8 + e] += s * tmp[e]; }
        }
        float ms = 0.f;
#pragma unroll
        for (int e = 0; e < 64; ++e) ms += acc[e] * acc[e];
        const float rn = __builtin_amdgcn_rsqf(ms * (1.0f / 64.0f) + 1e-6f);
#pragma unroll
        for (int c = 0; c < 8; ++c) { float g[8], o[8]; ld8(P_Z + (size_t)row * ZP + C_GR + h * 64 + c * 8, g);
#pragma unroll
            for (int e = 0; e < 8; ++e) o[e] = g[e] / (1.0f + __expf(-g[e])) * acc[c * 8 + e] * rn;
            st8(P_Y + (size_t)row * DM + Y_R + h * 64 + c * 8, o); }
    }
}
__device__ __forceinline__ void final_norm(const Frame& F0, const Args& A) {
    const Frame F = phase_frame(F0);
    const int gw = F.bid * NWAVES + F.wave, NGW = F.G * NWAVES;
    for (int m = gw; m < MROWS; m += NGW) {
        GAS f32x4* xr = (GAS f32x4*)(A.out + (size_t)m * DM) + F.lane; f32x4 v[4]; float s = 0.f;
#pragma unroll
        for (int j = 0; j < 4; ++j) { v[j] = xr[64 * j]; s += (v[j].x * v[j].x + v[j].y * v[j].y) + (v[j].z * v[j].z + v[j].w * v[j].w); }
        const float rs = 1.0f / sqrtf(wave_sum(s) * (1.0f / DM) + 1e-6f);
#pragma unroll
        for (int j = 0; j < 4; ++j) { const f32x4 g = ((const GAS f32x4*)A_FINAL_G)[64 * j + F.lane]; xr[64 * j] = v[j] * rs * g; }
    }
}

#ifndef MK_EN
#define MK_EN 0xFFFF
#endif
__global__ void __launch_bounds__(NTHR, 2) mk_fwd(Args args) {
    extern __shared__ __attribute__((aligned(16))) unsigned char lds[];
    const Args& A = args;
    Frame F;
    F.lds = (LAS unsigned char*)lds;
    F.tid = threadIdx.x; F.lane = F.tid & 63; F.wave = __builtin_amdgcn_readfirstlane(F.tid >> 6); F.G = gridDim.x; F.bid = blockIdx.x; F.ws = args.ws;
    for (int u = F.tid; u < (LDS_BYTES - LDSCTL_OFF) / 4; u += NTHR) ((LAS unsigned*)(F.lds + LDSCTL_OFF))[u] = 0u;
    __syncthreads();
    const int lo = args.ph_lo, hi = args.ph_hi;
    XcdBarrier bar; bar.bar = (unsigned*)(F.ws + WS_CTL) + CW_BAR; bar.x = 0; bar.st = nullptr;
    if (hi - lo > 1) bar = xcd_barrier_post((unsigned*)(F.ws + WS_CTL) + CW_BAR, (volatile LAS unsigned*)(F.lds + MISC_OFF) + 8);

    if (lo == 0) { if (MK_EN & 1) p0_prologue(F, A); if (hi > 1) xcd_barrier(bar); }
    for (int ph = (lo == 0 ? 1 : lo); ph < hi; ++ph) {
        if (ph == NPHASE - 1) break;
        if (ph != 0 && ph != NPHASE - 1) {
            const int layer = (ph - 1) / 7, s = (ph - 1) % 7;
            if (s == 0) { if (MK_EN & 4) {
                pg8::Gemm g{P_XB, wptr(F, layer, W_IN), MROWS, ZP, DM}; pg8::StaticOrder S; S.init(MROWS, ZP, F.G, F.bid);
                pg8::EpiIn E{P_Z, ZP, P_SSQ, P_ROPE};
                pg8::gemm_phase<pg8::EpiIn, pg8::StaticOrder, true, true>(F.lds + RING_OFF, g, S, E); }
            } else if (s == 1) {
                if (MK_EN & 8) mix_attn_simple(F, A, layer); if (MK_EN & 16) mix_pool_simple(F, A, layer); if (MK_EN & 32) mix_retU_simple(F, A);
            } else if (s == 2) {
                if (MK_EN & 64) mix_scan_simple(F, A);
            } else if (s == 3) {
                if (MK_EN & 128) mix_retout_simple(F, A);
            } else if (s == 4 || s == 6) { if (MK_EN & 256) {
                const bool dn = (s == 6);
                pg8::Gemm g{dn ? P_H : P_Y, wptr(F, layer, dn ? W_DN : W_OUT), MROWS, DM, dn ? FF : DM}; pg8::StaticOrder S; S.init(MROWS, DM, F.G, F.bid);
                pg8::EpiRes E{(layer == 0 && !dn) ? A_X : A.out, A.out, P_XB, P_SSQ};
                pg8::gemm_phase<pg8::EpiRes, pg8::StaticOrder, true, true>(F.lds + RING_OFF, g, S, E); }
            } else { if (MK_EN & 512) {
                pg8::Gemm g{P_XB, wptr(F, layer, W_UP), MROWS, FF, DM}; pg8::StaticOrder S; S.init(MROWS, FF, F.G, F.bid);
                pg8::EpiUp E{P_H, FF, P_SSQ};
                pg8::gemm_phase<pg8::EpiUp, pg8::StaticOrder, true, true>(F.lds + RING_OFF, g, S, E); }
            }
        }
        if (ph + 1 < hi) xcd_barrier(bar);
    }
    if (hi == NPHASE) { if (MK_EN & 2) final_norm(F, A); }
}

#ifndef MK_ONE_LAUNCH
#define MK_ONE_LAUNCH 0
#endif
extern "C" void kernel_launch(void* const* d_in, const int* in_sizes, int n_in, void* d_out, int out_size, void* d_ws, size_t ws_size, hipStream_t stream) {
    static int grid = 0;
    if (grid == 0) {
        if (n_in != 12 || in_sizes[0] != MROWS * DM || out_size != MROWS * DM || ws_size < WS_END) { fprintf(stderr, "kernel_launch: unexpected shapes (n_in %d, in0 %d, out %d, ws %zu); nothing launched\n", n_in, n_in > 0 ? in_sizes[0] : -1, out_size, ws_size); grid = -1; return; }
        int dev = 0, cus = 0, per_cu = 0;
        if (hipGetDevice(&dev) != hipSuccess || hipDeviceGetAttribute(&cus, hipDeviceAttributeMultiprocessorCount, dev) != hipSuccess) { grid = -1; return; }
        if (hipFuncSetAttribute((const void*)mk_fwd, hipFuncAttributeMaxDynamicSharedMemorySize, LDS_BYTES) != hipSuccess) { fprintf(stderr, "kernel_launch: hipFuncSetAttribute failed\n"); grid = -1; return; }
        if (hipOccupancyMaxActiveBlocksPerMultiprocessor(&per_cu, (const void*)mk_fwd, NTHR, LDS_BYTES) != hipSuccess || per_cu < 1) { fprintf(stderr, "kernel_launch: occupancy query says %d blocks per CU\n", per_cu); per_cu = 1; }
        (void)hipGetLastError();
        grid = cus;
    }
    if (grid < 0) return;
    (void)hipMemsetAsync((char*)d_ws + WS_CTL, 0, CTL_ZERO_BYTES, stream);
    Args a{};
    for (int i = 0; i < 12; ++i) a.in[i] = (const float*)d_in[i];
    a.out = (float*)d_out; a.ws = (unsigned char*)d_ws;
#if MK_ONE_LAUNCH
    a.ph_lo = 0; a.ph_hi = NPHASE;
    hipLaunchKernelGGL(mk_fwd, dim3(grid), dim3(NTHR), LDS_BYTES, stream, a);
#else
    for (int ph = 0; ph < NPHASE; ++ph) { a.ph_lo = ph; a.ph_hi = ph + 1; hipLaunchKernelGGL(mk_fwd, dim3(grid), dim3(NTHR), LDS_BYTES, stream, a); }
#endif
}
```

```cpp
#include <hip/hip_runtime.h>
#include <cstdio>
#include <cstdint>
namespace pg8 {
#define PG8_LAS __attribute__((address_space(3)))
typedef unsigned short bf16_t;
typedef short bf16x8 __attribute__((ext_vector_type(8)));
typedef float f32x4 __attribute__((ext_vector_type(4)));
typedef unsigned u32x4 __attribute__((ext_vector_type(4)));
constexpr int BM = 256, BK = 64, HALF = 128, HTB = HALF * BK * 2  , STAGE_BYTES = 8 * HTB, NXCD = 8, WGM = 4;

__host__ __device__ __forceinline__ int lds_byte(int r, int c) { const int st = (r >> 4) * 2 + (c >> 5), rr = r & 15, cc = c & 31, ob = rr * 64 + cc * 2; return st * 1024 + (ob ^ (((ob >> 9) & 1) << 5)); }
__host__ __device__ __forceinline__ void stage_rc(int b, int& R, int& C) { const int st = b / 1024, sb = b % 1024, swz = sb ^ (((sb >> 9) & 1) << 5); R = (st >> 1) * 16 + swz / 64; C = (st & 1) * 32 + (swz % 64) / 2; }
__host__ __device__ __forceinline__ int perm32(int rho) { const int n = rho >> 4, i = rho & 15; return 8 * (i >> 2) + 4 * n + (i & 3); }

struct Unit { int pm, pn; };
struct Gemm { const bf16_t* A; const bf16_t* Bt; int M, N, K; };

struct StaticOrder {
    int nM, nN, nwg, G, c;
    __host__ __device__ void init(int M, int N, int G_, int c_) { nM = M / BM; nN = N / BM; nwg = nM * nN; G = G_; c = c_; }
    __host__ __device__ bool next(int i, Unit& u) const {
        const long L = (long)i * G + c; if (L >= nwg) return false;
        int wgid = (int)L; { const int q = nwg / NXCD, r = nwg % NXCD, xcd = wgid % NXCD, off = wgid / NXCD; wgid = (xcd < r ? xcd * (q + 1) : r * (q + 1) + (xcd - r) * q) + off; }
        const int nig = WGM * nN, gid = wgid / nig, fm = gid * WGM, gsz = (nM - fm) < WGM ? (nM - fm) : WGM;
        u.pm = fm + ((wgid % nig) % gsz); u.pn = (wgid % nig) / gsz; return true;
    }
    __device__ __forceinline__ void a_ready(const Unit&) const {}
    __device__ __forceinline__ void done(const Unit&) const {}
};

struct PanelOrder {
    int nM, nN, G, vc;
    __host__ __device__ void init(int M, int N, int G_, int bid) { nM = M / BM; nN = N / BM; G = G_; vc = (G_ % 8 == 0) ? (bid & 7) * (G_ >> 3) + (bid >> 3) : bid; }
    __host__ __device__ bool next(int i, Unit& u) const {
        if (G & 3) { const long L = (long)i * G + vc; if (L >= (long)nM * nN) return false; u.pm = (int)(L / nN); u.pn = (int)(L % nN); return true; }
        const int pr = i * (G >> 2) + (vc >> 2), ip = pr / nM; u.pm = pr % nM; u.pn = (vc & 3) + 4 * ip; return u.pn < nN;
    }
    __device__ __forceinline__ void a_ready(const Unit&) const {}
    __device__ __forceinline__ void done(const Unit&) const {}
};

__device__ __forceinline__ unsigned cvt_pk_bf16(float lo, float hi) { unsigned r; asm volatile("v_cvt_pk_bf16_f32 %0, %1, %2" : "=v"(r) : "v"(lo), "v"(hi)); return r; }
typedef unsigned u32x2 __attribute__((ext_vector_type(2)));

__device__ __forceinline__ float row_rstd(const float* ssq, int row) {
    const f32x4* p = (const f32x4*)(ssq + (size_t)row * 16);
    const f32x4 a = p[0], b = p[1], c = p[2], d = p[3];
    const float s = ((a[0] + a[1]) + (a[2] + a[3])) + ((b[0] + b[1]) + (b[2] + b[3])) + ((c[0] + c[1]) + (c[2] + c[3])) + ((d[0] + d[1]) + (d[2] + d[3]));
    return __builtin_amdgcn_rsqf(s * (1.0f / 1024.0f) + 1e-6f);
}

template <class Sched> __device__ __forceinline__ void rstd_table(PG8_LAS float* tab, const float* ssq, const Sched& S) {
    int tid_ = threadIdx.x; asm volatile("" : "+v"(tid_));
    const int t = tid_ & 255, half = __builtin_amdgcn_readfirstlane(tid_ >> 8);
    f32x4 v[4][4]; bool ok[4];
#pragma unroll
    for (int j = 0; j < 4; ++j) { Unit u; ok[j] = S.next(half + 2 * j, u);
        if (ok[j]) { const f32x4* p = (const f32x4*)(ssq + (size_t)(u.pm * BM + t) * 16); v[j][0] = p[0]; v[j][1] = p[1]; v[j][2] = p[2]; v[j][3] = p[3]; } }
#pragma unroll
    for (int j = 0; j < 4; ++j) if (ok[j]) { const f32x4 a = v[j][0], b = v[j][1], c = v[j][2], d = v[j][3];
        const float s = ((a[0] + a[1]) + (a[2] + a[3])) + ((b[0] + b[1]) + (b[2] + b[3])) + ((c[0] + c[1]) + (c[2] + c[3])) + ((d[0] + d[1]) + (d[2] + d[3]));
        tab[(half + 2 * j) * 256 + t] = __builtin_amdgcn_rsqf(s * (1.0f / 1024.0f) + 1e-6f); }
    __syncthreads();
}

struct EpiIn {
    static constexpr bool PERM = true, ADJ = false, AFTER_DRAIN = false;
    bf16_t* Z; int ldz; PG8_LAS float* rstd; const float* rope; const float* ssq;
    template <class Sched> __device__ __forceinline__ void after_first_stage(const Sched& S) const { rstd_table(rstd, ssq, S); }
    __device__ __forceinline__ void operator()(const f32x4 (&acc)[2][2][4][2], const Unit& u, int wr, int wc, int fr, int fq, int ui) const {
        const int row0 = u.pm * BM + wr * 64 + fr, col0 = u.pn * BM + wc * 32 + 8 * fq;
        const bool rot0 = (2 * u.pn >= 5 && 2 * u.pn < 11), rot1 = (2 * u.pn + 1 >= 5 && 2 * u.pn + 1 < 11);
        if (rot0 || rot1) {
            const int i0 = ((wc * 32 + 8 * fq) & 63) >> 1;
            f32x4 cs[4][2]; u32x4 w[2][4][2];
#define PG8_IN_LOAD(ai) do { _Pragma("unroll") for (int m = 0; m < 4; ++m) { const f32x4* rp = (const f32x4*)(rope + ((size_t)((row0 + (ai) * HALF + m * 16) & 8191) * 32 + i0) * 2); cs[m][0] = rp[0]; cs[m][1] = rp[1]; } } while (0)
#define PG8_IN_COMP(ai) do { _Pragma("unroll") for (int m = 0; m < 4; ++m) { const float rs = rstd[ui * 256 + wr * 64 + fr + (ai) * HALF + m * 16]; const f32x4 c01 = cs[m][0], c23 = cs[m][1]; \
            _Pragma("unroll") for (int bj = 0; bj < 2; ++bj) { f32x4 v0 = acc[ai][bj][m][0] * rs, v1 = acc[ai][bj][m][1] * rs; \
                if (bj ? rot1 : rot0) { f32x4 w0, w1; \
                    w0[0] = v0[0] * c01[0] - v0[1] * c01[1]; w0[1] = v0[0] * c01[1] + v0[1] * c01[0]; w0[2] = v0[2] * c01[2] - v0[3] * c01[3]; w0[3] = v0[2] * c01[3] + v0[3] * c01[2]; \
                    w1[0] = v1[0] * c23[0] - v1[1] * c23[1]; w1[1] = v1[0] * c23[1] + v1[1] * c23[0]; w1[2] = v1[2] * c23[2] - v1[3] * c23[3]; w1[3] = v1[2] * c23[3] + v1[3] * c23[2]; v0 = w0; v1 = w1; } \
                u32x4 o; o.x = cvt_pk_bf16(v0[0], v0[1]); o.y = cvt_pk_bf16(v0[2], v0[3]); o.z = cvt_pk_bf16(v1[0], v1[1]); o.w = cvt_pk_bf16(v1[2], v1[3]); w[ai][m][bj] = o; } } } while (0)
#define PG8_IN_STORE(ai) do { _Pragma("unroll") for (int m = 0; m < 4; ++m) _Pragma("unroll") for (int bj = 0; bj < 2; ++bj) *(u32x4*)(Z + (size_t)(row0 + (ai) * HALF + m * 16) * ldz + col0 + bj * HALF) = w[ai][m][bj]; } while (0)
            PG8_IN_LOAD(0); PG8_IN_COMP(0); PG8_IN_LOAD(1); PG8_IN_STORE(0); PG8_IN_COMP(1); PG8_IN_STORE(1);
#undef PG8_IN_LOAD
#undef PG8_IN_COMP
#undef PG8_IN_STORE
        } else {
#pragma unroll
            for (int ai = 0; ai < 2; ++ai)
#pragma unroll
                for (int m = 0; m < 4; ++m) {
                    const int row = row0 + ai * HALF + m * 16; const float rs = rstd[ui * 256 + wr * 64 + fr + ai * HALF + m * 16];
#pragma unroll
                    for (int bj = 0; bj < 2; ++bj) {
                        const f32x4 v0 = acc[ai][bj][m][0] * rs, v1 = acc[ai][bj][m][1] * rs;
                        u32x4 w; w.x = cvt_pk_bf16(v0[0], v0[1]); w.y = cvt_pk_bf16(v0[2], v0[3]); w.z = cvt_pk_bf16(v1[0], v1[1]); w.w = cvt_pk_bf16(v1[2], v1[3]);
                        *(u32x4*)(Z + (size_t)row * ldz + col0 + bj * HALF) = w;
                    }
                }
        }
    }
};

struct EpiUp {
    static constexpr bool PERM = true, ADJ = true, AFTER_DRAIN = false;
    bf16_t* H; int ldh; PG8_LAS float* rstd; const float* ssq;
    template <class Sched> __device__ __forceinline__ void after_first_stage(const Sched& S) const { rstd_table(rstd, ssq, S); }
    __device__ __forceinline__ void operator()(const f32x4 (&acc)[2][2][4][2], const Unit& u, int wr, int wc, int fr, int fq, int ui) const {
        const int row0 = u.pm * BM + wr * 64 + fr, col0 = u.pn * BM + wc * 64 + 8 * fq;
#pragma unroll
        for (int ai = 0; ai < 2; ++ai)
#pragma unroll
            for (int m = 0; m < 4; ++m) {
                const int row = row0 + ai * HALF + m * 16; const float rs = rstd[ui * 256 + wr * 64 + fr + ai * HALF + m * 16];
#pragma unroll
                for (int bj = 0; bj < 2; ++bj) {
                    f32x4 v0 = acc[ai][bj][m][0] * rs, v1 = acc[ai][bj][m][1] * rs;
#pragma unroll
                    for (int e = 0; e < 4; ++e) { const float a = fmaxf(v0[e], 0.f), b = fmaxf(v1[e], 0.f); v0[e] = a * a; v1[e] = b * b; }
                    u32x4 w; w.x = cvt_pk_bf16(v0[0], v0[1]); w.y = cvt_pk_bf16(v0[2], v0[3]); w.z = cvt_pk_bf16(v1[0], v1[1]); w.w = cvt_pk_bf16(v1[2], v1[3]);
                    *(u32x4*)(H + (size_t)row * ldh + col0 + bj * 32) = w;
                }
            }
    }
};

struct EpiRes {
    static constexpr bool PERM = true, ADJ = true, AFTER_DRAIN = false;
    bf16_t* xb; float* ssq;
    template <class Sched> __device__ __forceinline__ void after_first_stage(const Sched&) const {}
    __device__ __forceinline__ void operator()(const f32x4 (&acc)[2][2][4][2], const Unit& u, int wr, int wc, int fr, int fq, int) const {
        const int row0 = u.pm * BM + wr * 64 + fr, col0 = u.pn * BM + wc * 64 + 8 * fq;
        u32x4 bv[4][2], w[2][4][2]; float sq[2][4];
#define PG8_RES_LOAD(ai) do { _Pragma("unroll") for (int m = 0; m < 4; ++m) _Pragma("unroll") for (int bj = 0; bj < 2; ++bj) bv[m][bj] = *(const u32x4*)(xb + (size_t)(row0 + (ai) * HALF + m * 16) * 1024 + col0 + bj * 32); } while (0)
#define PG8_RES_COMP(ai) do { _Pragma("unroll") for (int m = 0; m < 4; ++m) { float s = 0.f; _Pragma("unroll") for (int bj = 0; bj < 2; ++bj) { const u32x4 b = bv[m][bj]; f32x4 x0, x1; \
            x0[0] = __uint_as_float(b.x << 16) + acc[ai][bj][m][0][0]; x0[1] = __uint_as_float(b.x & 0xffff0000u) + acc[ai][bj][m][0][1]; \
            x0[2] = __uint_as_float(b.y << 16) + acc[ai][bj][m][0][2]; x0[3] = __uint_as_float(b.y & 0xffff0000u) + acc[ai][bj][m][0][3]; \
            x1[0] = __uint_as_float(b.z << 16) + acc[ai][bj][m][1][0]; x1[1] = __uint_as_float(b.z & 0xffff0000u) + acc[ai][bj][m][1][1]; \
            x1[2] = __uint_as_float(b.w << 16) + acc[ai][bj][m][1][2]; x1[3] = __uint_as_float(b.w & 0xffff0000u) + acc[ai][bj][m][1][3]; \
            u32x4 o; o.x = cvt_pk_bf16(x0[0], x0[1]); o.y = cvt_pk_bf16(x0[2], x0[3]); o.z = cvt_pk_bf16(x1[0], x1[1]); o.w = cvt_pk_bf16(x1[2], x1[3]); w[ai][m][bj] = o; \
            s += ((x0[0] * x0[0] + x0[1] * x0[1]) + (x0[2] * x0[2] + x0[3] * x0[3])) + ((x1[0] * x1[0] + x1[1] * x1[1]) + (x1[2] * x1[2] + x1[3] * x1[3])); } \
            s += __shfl_xor(s, 16); s += __shfl_xor(s, 32); sq[ai][m] = s; } } while (0)
#define PG8_RES_STORE(ai) do { _Pragma("unroll") for (int m = 0; m < 4; ++m) { const int row = row0 + (ai) * HALF + m * 16; _Pragma("unroll") for (int bj = 0; bj < 2; ++bj) *(u32x4*)(xb + (size_t)row * 1024 + col0 + bj * 32) = w[ai][m][bj]; \
            if (fq == 0) ssq[(size_t)row * 16 + u.pn * 4 + wc] = sq[ai][m]; } } while (0)
        PG8_RES_LOAD(0); PG8_RES_COMP(0); PG8_RES_LOAD(1); PG8_RES_STORE(0); PG8_RES_COMP(1); PG8_RES_STORE(1);
#undef PG8_RES_LOAD
#undef PG8_RES_COMP
#undef PG8_RES_STORE
    }
};

template <class Epi, class Sched, bool ALIGN_EPI = false, bool SP2 = false>
__device__ __forceinline__ void gemm_phase(PG8_LAS unsigned char* lds, const Gemm g, const Sched& S, const Epi& E) {
    int tid_ = threadIdx.x; asm volatile("" : "+v"(tid_));
    const int tid = tid_, wid = __builtin_amdgcn_readfirstlane(tid >> 6), lane = tid & 63, wr = wid >> 2, wc = wid & 3, fr = lane & 15, fq = lane >> 4;
    const int K = g.K, nt = K / BK;
    unsigned voffA[2], voffB[2];
#pragma unroll
    for (int i = 0; i < 2; ++i) { int R, C; stage_rc(tid * 16 + i * 8192, R, C); const int Rb = Epi::PERM ? ((Epi::ADJ ? ((R >> 5) << 6) : (R & ~31)) + perm32(R & 31)) : R;
        voffA[i] = (unsigned)(R * K + C) * 2u; voffB[i] = (unsigned)(Rb * K + C) * 2u; }
    const size_t kstep = (size_t)(BK * 2);
    const size_t hstep = (size_t)HALF * K * 2;
    const size_t tstep = 2 * hstep;
    const size_t bhstep = Epi::ADJ ? (size_t)32 * K * 2 : hstep;
    const unsigned ldsw = (unsigned)wid * 1024u;
    const int aoff = lds_byte(wr * 64 + fr, fq * 8), boff = lds_byte(wc * 32 + fr, fq * 8);
#define PG8_SA(b, h) (((b) * 2 + (h)) * HTB)
#define PG8_SB(b, h) ((4 + (b) * 2 + (h)) * HTB)
#define PG8_STAGE(bufoff, gbase, voff) do { _Pragma("unroll") for (int _i = 0; _i < 2; ++_i) \
        __builtin_amdgcn_global_load_lds((const unsigned*)((const char*)(gbase) + (voff)[_i]), (PG8_LAS unsigned*)(lds + (bufoff) + ldsw + _i * 8192), 16, 0, 0); } while (0)
#define PG8_LDA(dst, b, h) do { _Pragma("unroll") for (int m = 0; m < 4; ++m) _Pragma("unroll") for (int k = 0; k < 2; ++k) dst[m][k] = *(const PG8_LAS bf16x8*)(lds + PG8_SA(b, h) + aoff + m * 2048 + k * 1024); } while (0)
#define PG8_LDB(dst, b, h) do { _Pragma("unroll") for (int n = 0; n < 2; ++n) _Pragma("unroll") for (int k = 0; k < 2; ++k) dst[n][k] = *(const PG8_LAS bf16x8*)(lds + PG8_SB(b, h) + boff + n * 2048 + k * 1024); } while (0)
#define PG8_MMA(ai, bj, At, Bt) do { __builtin_amdgcn_s_setprio(1); _Pragma("unroll") for (int m = 0; m < 4; ++m) _Pragma("unroll") for (int n = 0; n < 2; ++n) _Pragma("unroll") for (int k = 0; k < 2; ++k) \
        acc[ai][bj][m][n] = __builtin_amdgcn_mfma_f32_16x16x32_bf16(Bt[n][k], At[m][k], acc[ai][bj][m][n], 0, 0, 0); __builtin_amdgcn_s_setprio(0); } while (0)
#define PG8_WAIT_V(n) asm volatile("s_waitcnt vmcnt(" #n ")" ::: "memory")
#define PG8_WAIT_L(n) asm volatile("s_waitcnt lgkmcnt(" #n ")" ::: "memory")
#define PG8_BAR __builtin_amdgcn_s_barrier()
#define PG8_SCHED __builtin_amdgcn_sched_barrier(0)
    Unit cur, nxt; int ui = 0;
    if (!S.next(0, cur)) return;
    f32x4 acc[2][2][4][2];
#pragma unroll
    for (int a = 0; a < 2; ++a)
#pragma unroll
        for (int b = 0; b < 2; ++b)
#pragma unroll
            for (int m = 0; m < 4; ++m)
#pragma unroll
                for (int n = 0; n < 2; ++n) acc[a][b][m][n] = (f32x4){0.f, 0.f, 0.f, 0.f};
    bf16x8 At[4][2], B0[2][2], B1[2][2];
    const char* cA = (const char*)g.A + (size_t)cur.pm * tstep; const char* cB = (const char*)g.Bt + (size_t)cur.pn * tstep;
    S.a_ready(cur);
    if constexpr (SP2) {
        PG8_STAGE(PG8_SB(0, 0), cB, voffB); PG8_STAGE(PG8_SB(0, 1), cB + bhstep, voffB); PG8_STAGE(PG8_SA(0, 0), cA, voffA); PG8_STAGE(PG8_SA(0, 1), cA + hstep, voffA);
        E.after_first_stage(S);
        if (wr == 1) PG8_BAR;
        PG8_WAIT_V(2); PG8_BAR;
        PG8_STAGE(PG8_SB(1, 0), cB + kstep, voffB); PG8_STAGE(PG8_SA(1, 0), cA + kstep, voffA); PG8_STAGE(PG8_SB(1, 1), cB + bhstep + kstep, voffB);
        PG8_WAIT_V(6); PG8_BAR;
    } else {
        PG8_STAGE(PG8_SB(0, 0), cB, voffB); PG8_STAGE(PG8_SA(0, 0), cA, voffA); PG8_STAGE(PG8_SB(0, 1), cB + bhstep, voffB); PG8_STAGE(PG8_SA(0, 1), cA + hstep, voffA);
        if (wr == 1) PG8_BAR;
        PG8_WAIT_V(4); PG8_BAR;
        PG8_STAGE(PG8_SB(1, 0), cB + kstep, voffB); PG8_STAGE(PG8_SA(1, 0), cA + kstep, voffA); PG8_STAGE(PG8_SB(1, 1), cB + bhstep + kstep, voffB);
        PG8_WAIT_V(6); PG8_BAR;
    }
    for (;;) {
        const bool has_next = S.next(ui + 1, nxt);
        const char* nA = has_next ? (const char*)g.A + (size_t)nxt.pm * tstep : cA; const char* nB = has_next ? (const char*)g.Bt + (size_t)nxt.pn * tstep : cB;
        for (int t = 0; t < nt; t += 2) {
            const bool last = (t == nt - 2);
            const char* a1 = cA + (size_t)(t + 1) * kstep;
            const char* a2 = last ? nA : cA + (size_t)(t + 2) * kstep; const char* b2 = last ? nB : cB + (size_t)(t + 2) * kstep;
            const char* a3 = a2 + kstep; const char* b3 = b2 + kstep;
            if (last && has_next) S.a_ready(nxt);
            if constexpr (SP2) {
            PG8_LDB(B0, 0, 0); PG8_LDB(B1, 0, 1); PG8_SCHED; PG8_LDA(At, 0, 0); PG8_STAGE(PG8_SA(1, 1), a1 + hstep, voffA);
            PG8_WAIT_V(8); PG8_WAIT_L(0); PG8_BAR; PG8_MMA(0, 0, At, B0); PG8_MMA(0, 1, At, B1); PG8_BAR; PG8_SCHED;
            PG8_LDA(At, 0, 1); PG8_STAGE(PG8_SB(0, 0), b2, voffB); PG8_STAGE(PG8_SB(0, 1), b2 + bhstep, voffB); PG8_STAGE(PG8_SA(0, 0), a2, voffA);
            PG8_WAIT_V(8); PG8_WAIT_L(0); PG8_BAR; PG8_MMA(1, 0, At, B0); PG8_MMA(1, 1, At, B1); PG8_BAR; PG8_SCHED;
            PG8_LDB(B0, 1, 0); PG8_LDB(B1, 1, 1); PG8_SCHED; PG8_LDA(At, 1, 0); PG8_STAGE(PG8_SA(0, 1), a2 + hstep, voffA);
            PG8_WAIT_V(8); PG8_WAIT_L(0); PG8_BAR; PG8_MMA(0, 0, At, B0); PG8_MMA(0, 1, At, B1); PG8_BAR; PG8_SCHED;
            PG8_LDA(At, 1, 1); PG8_STAGE(PG8_SB(1, 0), b3, voffB); PG8_STAGE(PG8_SB(1, 1), b3 + bhstep, voffB); PG8_STAGE(PG8_SA(1, 0), a3, voffA);
            PG8_WAIT_V(8); PG8_WAIT_L(0); PG8_BAR; PG8_MMA(1, 0, At, B0); PG8_MMA(1, 1, At, B1); PG8_BAR; PG8_SCHED;
            } else {
            PG8_LDB(B0, 0, 0); PG8_SCHED; PG8_LDA(At, 0, 0); PG8_STAGE(PG8_SA(1, 1), a1 + hstep, voffA);
            PG8_WAIT_L(8); PG8_BAR; PG8_WAIT_L(0); PG8_MMA(0, 0, At, B0); PG8_BAR; PG8_SCHED;
            PG8_LDB(B1, 0, 1); PG8_STAGE(PG8_SB(0, 0), b2, voffB);
            PG8_BAR; PG8_WAIT_L(0); PG8_MMA(0, 1, At, B1); PG8_BAR;
            PG8_LDA(At, 0, 1); PG8_STAGE(PG8_SA(0, 0), a2, voffA);
            PG8_BAR; PG8_WAIT_L(0); PG8_MMA(1, 0, At, B0); PG8_BAR; PG8_SCHED;
            PG8_STAGE(PG8_SB(0, 1), b2 + bhstep, voffB);
            PG8_WAIT_V(6); PG8_BAR; PG8_MMA(1, 1, At, B1); PG8_BAR;
            PG8_LDB(B0, 1, 0); PG8_SCHED; PG8_LDA(At, 1, 0); PG8_STAGE(PG8_SA(0, 1), a2 + hstep, voffA);
            PG8_WAIT_L(8); PG8_BAR; PG8_WAIT_L(0); PG8_MMA(0, 0, At, B0); PG8_BAR; PG8_SCHED;
            PG8_LDB(B1, 1, 1); PG8_STAGE(PG8_SB(1, 0), b3, voffB);
            PG8_BAR; PG8_WAIT_L(0); PG8_MMA(0, 1, At, B1); PG8_BAR;
            PG8_LDA(At, 1, 1); PG8_STAGE(PG8_SA(1, 0), a3, voffA);
            PG8_BAR; PG8_WAIT_L(0); PG8_MMA(1, 0, At, B0); PG8_BAR; PG8_SCHED;
            PG8_STAGE(PG8_SB(1, 1), b3 + bhstep, voffB);
            PG8_WAIT_V(6); PG8_BAR; PG8_MMA(1, 1, At, B1); PG8_BAR;
            }
        }
        if constexpr (ALIGN_EPI) { if (wr == 0) PG8_BAR; }
        if constexpr (!Epi::AFTER_DRAIN) {
            E(acc, cur, wr, wc, fr, fq, ui);
            S.done(cur); }
        if (!has_next) break;
#pragma unroll
        for (int a = 0; a < 2; ++a)
#pragma unroll
            for (int b = 0; b < 2; ++b)
#pragma unroll
                for (int m = 0; m < 4; ++m)
#pragma unroll
                    for (int n = 0; n < 2; ++n) acc[a][b][m][n] = (f32x4){0.f, 0.f, 0.f, 0.f};
        cur = nxt; cA = nA; cB = nB; ++ui;
        if constexpr (ALIGN_EPI) { if (wr == 1) PG8_BAR; }
    }
    PG8_WAIT_V(0);
    if constexpr (!ALIGN_EPI) { if (wr == 0) PG8_BAR; }
    PG8_BAR;
    if constexpr (Epi::AFTER_DRAIN) { E.fused(acc, cur, wr, wc, fr, fq, lds, wid, lane); S.done(cur); }

#undef PG8_SA
#undef PG8_SB
#undef PG8_STAGE
#undef PG8_LDA
#undef PG8_LDB
#undef PG8_MMA
#undef PG8_WAIT_V
#undef PG8_WAIT_L
#undef PG8_BAR
#undef PG8_SCHED
}
}

constexpr int NWAVES = 8, NTHR = NWAVES * 64;
constexpr int SEQ = 8192, DM = 1024, MROWS = 2 * SEQ, NIN = 2432, ZP = 2560, FF = 4096, DEPTH = 4;
constexpr int C_QA = 0, C_KA = 384, C_VA = 512, C_QR = 640, C_KR = 1024, C_VR = 1408, C_GR = 1792, C_UP = 2176;
constexpr int Y_A = 0, Y_R = 384, Y_P = 768;
constexpr int NPHASE = 2 + 7 * DEPTH;

constexpr size_t MiB = 1u << 20;
constexpr size_t WS_CTL = 0, CTL_ZERO_BYTES = 64 * 1024;
constexpr size_t WS_SSQ = 1 * MiB;
constexpr size_t WS_W = 2 * MiB;
constexpr size_t W_LAYER = 23 * MiB, W_IN = 0, W_OUT = 5 * MiB, W_UP = 7 * MiB, W_DN = 15 * MiB;
constexpr size_t WS_XB = 94 * MiB;
constexpr size_t WS_H = 126 * MiB;
constexpr size_t WS_Z = 126 * MiB;
constexpr size_t WS_Y = 206 * MiB;
constexpr size_t WS_U = 238 * MiB;
constexpr size_t WS_ROPE = 254 * MiB;
constexpr size_t WS_END = 256 * MiB;
static_assert(WS_W + DEPTH * W_LAYER <= WS_XB && WS_Z + (size_t)MROWS * ZP * 2 <= WS_Y && WS_Y + (size_t)MROWS * DM * 2 <= WS_U && WS_U + 12 * MiB <= WS_H + 128 * MiB && WS_H + 128 * MiB <= WS_ROPE, "d_ws map");
constexpr size_t WS_BIAST = 128 * 1024;
constexpr size_t WS_PWT = 256 * 1024;
constexpr int CW_BAR = 4096;

constexpr int RING_OFF = 0, RING_BYTES = 131072;
constexpr int MIX_BYTES = 143360;
constexpr int LDSCTL_OFF = MIX_BYTES, MISC_OFF = LDSCTL_OFF + 320;
constexpr int LDS_BYTES = 147456;

#define GAS __attribute__((address_space(1)))
#define LAS __attribute__((address_space(3)))
typedef unsigned short bf16;
typedef unsigned v4u __attribute__((ext_vector_type(4)));
typedef unsigned v2u __attribute__((ext_vector_type(2)));
typedef float f32x4 __attribute__((ext_vector_type(4)));
typedef GAS unsigned gu32;
#define LDS_WAIT() asm volatile("s_waitcnt lgkmcnt(0)" ::: "memory")
__device__ __forceinline__ unsigned f2bf(float f) { unsigned u = __builtin_bit_cast(unsigned, f); return (u + 0x7fffu + ((u >> 16) & 1u)) >> 16; }
__device__ __forceinline__ unsigned pk2(float lo, float hi) { return f2bf(lo) | (f2bf(hi) << 16); }
__device__ __forceinline__ float bflo(unsigned w) { return __uint_as_float(w << 16); }
__device__ __forceinline__ float bfhi(unsigned w) { return __uint_as_float(w & 0xffff0000u); }
__device__ __forceinline__ float bf1(const bf16* p) { return __uint_as_float((unsigned)(*p) << 16); }
__device__ __forceinline__ void ld8(const bf16* p, float (&o)[8]) { const v4u w = *(const v4u*)p; o[0] = bflo(w.x); o[1] = bfhi(w.x); o[2] = bflo(w.y); o[3] = bfhi(w.y); o[4] = bflo(w.z); o[5] = bfhi(w.z); o[6] = bflo(w.w); o[7] = bfhi(w.w); }
__device__ __forceinline__ void st8(bf16* p, const float (&o)[8]) { v4u w; w.x = pk2(o[0], o[1]); w.y = pk2(o[2], o[3]); w.z = pk2(o[4], o[5]); w.w = pk2(o[6], o[7]); *(v4u*)p = w; }
__device__ __forceinline__ float wave_sum(float v) {
#pragma unroll
    for (int o = 1; o < 64; o <<= 1) v += __shfl_xor(v, o);
    return v;
}
__device__ __constant__ unsigned char kT5[128] = {0,1,2,3,4,5,6,7,8,9,10,11,12,13,14,15,16,16,16,17,17,18,18,18,19,19,19,20,20,20,20,21,21,21,21,22,22,22,22,22,23,23,23,23,23,23,24,24,24,24,24,24,25,25,25,25,25,25,25,26,26,26,26,26,26,26,26,27,27,27,27,27,27,27,27,27,27,28,28,28,28,28,28,28,28,28,28,29,29,29,29,29,29,29,29,29,29,29,29,30,30,30,30,30,30,30,30,30,30,30,30,30,30,31,31,31,31,31,31,31,31,31,31,31,31,31,31,31};
__device__ __forceinline__ float ret_lg(int h) { return log1pf(-exp2f(-5.0f - (float)h)); }
#define XB_TMO      128
#define XB_XCNT(j)  (256  + 64 * (j))
#define XB_XSUB(j)  (1280 + 64 * (j))
#define XB_XGEN(j)  (2304 + 64 * (j))
#define XB_TOP      3328
#define XB_TOPGEN   3392
#define XCD_BAR_WORDS 3456
#define XB_SPIN_CAP (1u << 18)

__device__ __forceinline__ unsigned xb_ld(unsigned* p)              { return __hip_atomic_load(p, __ATOMIC_RELAXED, __HIP_MEMORY_SCOPE_AGENT); }
__device__ __forceinline__ unsigned xb_add(unsigned* p, unsigned v) { return __hip_atomic_fetch_add(p, v, __ATOMIC_RELAXED, __HIP_MEMORY_SCOPE_AGENT); }
__device__ __forceinline__ unsigned xb_xcc_id() { return (unsigned)__builtin_amdgcn_s_getreg((3 << 11) | 20) & 0xFu; }
#define XB_SPIN(cond, bar) do { unsigned _sp = 0; while (cond) { __builtin_amdgcn_s_sleep(1); \
    if ((++_sp & 255u) == 0u) { if (xb_ld(&(bar)[XB_TMO])) break; if (_sp > XB_SPIN_CAP) { atomicAdd(&(bar)[XB_TMO], 1u); break; } } } } while (0)

struct XcdBarrier {
    unsigned* bar; unsigned x;
    volatile LAS unsigned* st;
};

__device__ __forceinline__ XcdBarrier xcd_barrier_post(unsigned* bar, volatile LAS unsigned* st) {
    XcdBarrier b; b.bar = bar; b.x = xb_xcc_id(); b.st = st;
    if (threadIdx.x == 0) (void)xb_add(&bar[XB_XCNT(b.x)], 1u);
    return b;
}
__device__ __forceinline__ void xcd_barrier_complete(unsigned* bar, unsigned x, unsigned& nloc, unsigned& nx) {
    const unsigned G = gridDim.x * gridDim.y * gridDim.z;
    unsigned sum, cnt, mine, sp = 0u;
    for (;;) {
        sum = 0u; cnt = 0u; mine = 0u;
#pragma unroll
        for (unsigned j = 0; j < 16; ++j) { const unsigned c = xb_ld(&bar[XB_XCNT(j)]); sum += c; cnt += (c > 0u) ? 1u : 0u; mine = (j == x) ? c : mine; }
        if (sum == G) break;
        __builtin_amdgcn_s_sleep(1);
        if ((++sp & 255u) == 0u) { if (xb_ld(&bar[XB_TMO])) break; if (sp > XB_SPIN_CAP) { atomicAdd(&bar[XB_TMO], 1u); break; } }
    }
    nloc = mine > 0u ? mine : 1u; nx = cnt > 0u ? cnt : 1u;
}

__device__ __forceinline__ void xcd_barrier(const XcdBarrier& b) {
    asm volatile("s_waitcnt vmcnt(0)" ::: "memory");
    __syncthreads();
    if (threadIdx.x == 0) {
        unsigned* bar = b.bar;
        __builtin_amdgcn_s_waitcnt(0);
        unsigned nloc = b.st[0], nx = b.st[1];
        if (nloc == 0u) { xcd_barrier_complete(bar, b.x, nloc, nx); b.st[0] = nloc; b.st[1] = nx; }
        const unsigned old = xb_add(&bar[XB_XSUB(b.x)], 1u);
        const unsigned gen = old / nloc;
        if (old + 1u == (gen + 1u) * nloc) {
            __builtin_amdgcn_fence(__ATOMIC_RELEASE, "agent");
            asm volatile("s_waitcnt vmcnt(0)" ::: "memory");
            const unsigned og = xb_add(&bar[XB_TOP], 1u);
            const unsigned tg = og / nx;
            if (og + 1u == (tg + 1u) * nx) xb_add(&bar[XB_TOPGEN], 1u);
            else XB_SPIN(xb_ld(&bar[XB_TOPGEN]) == tg, bar);
            __builtin_amdgcn_fence(__ATOMIC_ACQUIRE, "agent");
            xb_add(&bar[XB_XGEN(b.x)], 1u);
            asm volatile("s_waitcnt vmcnt(0)" ::: "memory");
        } else {
            XB_SPIN(xb_ld(&bar[XB_XGEN(b.x)]) == gen, bar);
            __builtin_amdgcn_fence(__ATOMIC_ACQUIRE, "agent");
            asm volatile("s_waitcnt vmcnt(0)" ::: "memory");
        }
    }
    __syncthreads();
}

struct Args { const float* in[12]; float* out; unsigned char* ws; int ph_lo, ph_hi; };
struct Frame {
    LAS unsigned char* lds;
    int tid, lane, wave, G, bid;
    GAS unsigned char* ws;
};
__device__ __forceinline__ Frame phase_frame(const Frame& F0) { Frame F = F0; int t = threadIdx.x; asm volatile("" : "+v"(t)); F.tid = t; F.lane = t & 63; F.wave = __builtin_amdgcn_readfirstlane(t >> 6);
    unsigned long long w = (unsigned long long)F0.ws; asm volatile("" : "+s"(w)); F.ws = (GAS unsigned char*)w;
    return F; }
#define A_X        (A.in[0])
#define A_ATTN_G   (A.in[1])
#define A_W_IN     (A.in[2])
#define A_SINKS    (A.in[3])
#define A_RELB     (A.in[4])
#define A_POOLW    (A.in[5])
#define A_POOLS    (A.in[6])
#define A_W_OUT    (A.in[7])
#define A_MLP_G    (A.in[8])
#define A_W_UP     (A.in[9])
#define A_W_DOWN   (A.in[10])
#define A_FINAL_G  (A.in[11])
#define P_SSQ ((float*)(GAS float*)(F.ws + WS_SSQ))
#define P_XB ((bf16*)(GAS bf16*)(F.ws + WS_XB))
#define P_Z ((bf16*)(GAS bf16*)(F.ws + WS_Z))
#define P_Y ((bf16*)(GAS bf16*)(F.ws + WS_Y))
#define P_H ((bf16*)(GAS bf16*)(F.ws + WS_H))
#define P_U ((float*)(GAS float*)(F.ws + WS_U))
#define P_ROPE ((float*)(GAS float*)(F.ws + WS_ROPE))
#define P_BIAST ((float*)(GAS float*)(F.ws + WS_BIAST))
#define P_PWT ((bf16*)(GAS bf16*)(F.ws + WS_PWT))
__device__ __forceinline__ bf16* wptr(const Frame& F, int layer, size_t off) { return (bf16*)(GAS bf16*)(F.ws + WS_W + (size_t)layer * W_LAYER + off); }

#ifndef CONV_AHEAD
#define CONV_AHEAD 1
#endif
struct TItem { const float* W; bf16* WT; const float* gk; int K, N, k0, n0, colmode; };
__device__ __forceinline__ TItem p0_item(const Frame& F, const Args& A, int it) {
    constexpr int I_IN = (DM / 64) * (NIN / 32), I_OUT = (DM / 64) * (DM / 32), I_UP = (DM / 64) * (FF / 32), I_DN = (FF / 64) * (DM / 32), I_L = I_IN + I_OUT + I_UP + I_DN;
    const int l = it / I_L; int r = it % I_L; TItem t;
    if (r < I_IN) { t.W = A_W_IN + (size_t)l * DM * NIN; t.WT = wptr(F, l, W_IN); t.gk = A_ATTN_G + l * DM; t.K = DM; t.N = NIN; t.colmode = 1; }
    else if ((r -= I_IN) < I_OUT) { t.W = A_W_OUT + (size_t)l * DM * DM; t.WT = wptr(F, l, W_OUT); t.gk = nullptr; t.K = DM; t.N = DM; t.colmode = 0; }
    else if ((r -= I_OUT) < I_UP) { t.W = A_W_UP + (size_t)l * DM * FF; t.WT = wptr(F, l, W_UP); t.gk = A_MLP_G + l * DM; t.K = DM; t.N = FF; t.colmode = 0; }
    else { r -= I_UP; t.W = A_W_DOWN + (size_t)l * FF * DM; t.WT = wptr(F, l, W_DN); t.gk = nullptr; t.K = FF; t.N = DM; t.colmode = 0; }
    const int nblk = t.N / 32; t.k0 = 64 * (r / nblk); t.n0 = 32 * (r % nblk);
    return t;
}
__device__ __forceinline__ void p0_item_load(const TItem& t, int lane, float (&v)[32], f32x4 (&g)[2]) {
    const float* src = t.W + (size_t)(t.k0 + (lane >> 5)) * t.N + t.n0 + (lane & 31);
#pragma unroll
    for (int i = 0; i < 32; ++i) v[i] = src[(size_t)(2 * i) * t.N];
    if (t.gk) { const f32x4* gp = (const f32x4*)(t.gk + t.k0 + 8 * (lane & 7)); g[0] = gp[0]; g[1] = gp[1]; } else { g[0] = (f32x4){1.f, 1.f, 1.f, 1.f}; g[1] = g[0]; }
}
__device__ __forceinline__ void p0_item_store(const TItem& t, int lane, const float (&v)[32], const f32x4 (&g)[2], LAS float* scr) {
#pragma unroll
    for (int i = 0; i < 32; ++i) scr[(2 * i + (lane >> 5)) * 33 + (lane & 31)] = v[i];
    LDS_WAIT(); asm volatile("" ::: "memory");
    const int c = lane & 7;
#pragma unroll
    for (int j = 0; j < 4; ++j) { const int n = (lane >> 3) + 8 * j, ncol = t.n0 + n; const LAS float* s = scr + (8 * c) * 33 + n;
        const float cs = (t.colmode && (ncol < C_KA || (ncol >= C_KR && ncol < C_VR))) ? 0.125f : 1.0f;
        v4u o; o.x = pk2(s[0 * 33] * (g[0][0] * cs), s[1 * 33] * (g[0][1] * cs)); o.y = pk2(s[2 * 33] * (g[0][2] * cs), s[3 * 33] * (g[0][3] * cs));
        o.z = pk2(s[4 * 33] * (g[1][0] * cs), s[5 * 33] * (g[1][1] * cs)); o.w = pk2(s[6 * 33] * (g[1][2] * cs), s[7 * 33] * (g[1][3] * cs));
        *(GAS v4u*)(t.WT + (size_t)ncol * t.K + t.k0 + 8 * c) = o; }
    LDS_WAIT(); asm volatile("" ::: "memory");
}
__device__ __forceinline__ void convert_weights(const Frame& F, const Args& A, int l0, int l1, int gw, int NGW) {
    LAS float* scr = (LAS float*)(F.lds + RING_OFF + F.wave * 16384);
    constexpr int I_L = (DM / 64) * (NIN / 32) + (DM / 64) * (DM / 32) + (DM / 64) * (FF / 32) + (FF / 64) * (DM / 32);
    const int first = l0 * I_L, end = l1 * I_L;
    if (first + gw < end) {
        TItem cur = p0_item(F, A, first + gw); float va[32]; f32x4 ga[2]; p0_item_load(cur, F.lane, va, ga);
        for (int it = first + gw; it < end; it += NGW) {
            const bool more = it + NGW < end; TItem nxt = cur; float vb[32]; f32x4 gb[2];
            if (more) { nxt = p0_item(F, A, it + NGW); p0_item_load(nxt, F.lane, vb, gb); }
            p0_item_store(cur, F.lane, va, ga, scr);
            if (more) { cur = nxt;
#pragma unroll
                for (int i = 0; i < 32; ++i) va[i] = vb[i];
                ga[0] = gb[0]; ga[1] = gb[1]; }
        }
    }
    for (int it = gw; it < (l1 - l0) * (ZP - NIN); it += NGW) { const int l = l0 + it / (ZP - NIN), n = NIN + it % (ZP - NIN);
        GAS v4u* o = (GAS v4u*)(wptr(F, l, W_IN) + (size_t)n * DM) + F.lane; o[0] = (v4u){0u, 0u, 0u, 0u}; o[64] = (v4u){0u, 0u, 0u, 0u}; }
}
__device__ __forceinline__ void p0_prologue(const Frame& F0, const Args& A) {
    const Frame F = phase_frame(F0);
    const int gw = F.bid * NWAVES + F.wave, NGW = F.G * NWAVES;
    convert_weights(F, A, 0, CONV_AHEAD ? 1 : DEPTH, gw, NGW);
    for (int it = (F.bid * NTHR + F.tid); it < SEQ * 32; it += F.G * NTHR) { const int pos = it >> 5, i = it & 31;
        const float lin = (float)i * (1.0f / 31.0f); const float inv = 1.0f / powf(10000.0f, lin); const float ang = (float)pos * inv;
        const double a = (double)ang; const double k = rint(a * 0.15915494309189535); const float r = (float)(a - k * 6.283185307179586);
        P_ROPE[2 * it] = cosf(r); P_ROPE[2 * it + 1] = sinf(r); }
    for (int it = F.bid * NTHR + F.tid; it < 6 * 192; it += F.G * NTHR) { const int hq = it / 192, dist = it % 192 - 32;
        P_BIAST[it] = (dist >= 0 && dist < 128) ? A_RELB[(int)kT5[dist] * 6 + hq] : -1e30f; }
    for (int it = F.bid * NTHR + F.tid; it < DEPTH * 4 * 64 * 64; it += F.G * NTHR) { const int c = it & 63, d = (it >> 6) & 63, lg_ = it >> 12;
        P_PWT[it] = (bf16)f2bf(A_POOLW[((size_t)lg_ * 64 + c) * 64 + d] * A_POOLS[(lg_ >> 2) * 256 + (lg_ & 3) * 64 + d]); }
    for (int m = gw; m < MROWS; m += NGW) {
        const GAS f32x4* xr = (const GAS f32x4*)(A_X + (size_t)m * DM) + F.lane; f32x4 v[4]; float s = 0.f;
#pragma unroll
        for (int j = 0; j < 4; ++j) { v[j] = xr[64 * j]; s += (v[j].x * v[j].x + v[j].y * v[j].y) + (v[j].z * v[j].z + v[j].w * v[j].w); }
        s = wave_sum(s);
        GAS v2u* o8 = (GAS v2u*)(P_XB + (size_t)m * DM) + F.lane;
#pragma unroll
        for (int j = 0; j < 4; ++j) { v2u w; w.x = pk2(v[j].x, v[j].y); w.y = pk2(v[j].z, v[j].w); o8[64 * j] = w; }
        if (F.lane < 16) P_SSQ[(size_t)m * 16 + F.lane] = F.lane == 0 ? s : 0.f;
    }
}


typedef short bf16x8 __attribute__((ext_vector_type(8)));
typedef float f32x16 __attribute__((ext_vector_type(16)));
typedef float f32x2_t __attribute__((ext_vector_type(2))); typedef __bf16 bf16x2_t __attribute__((ext_vector_type(2)));
typedef short v4i16_t __attribute__((ext_vector_type(4)));
__device__ __forceinline__ unsigned cvtpk(float lo, float hi) { f32x2_t v = {lo, hi}; bf16x2_t b = __builtin_convertvector(v, bf16x2_t); return __builtin_bit_cast(unsigned, b); }
__device__ __forceinline__ int crow(int r, int hi) { return (r & 3) + 8 * (r >> 2) + 4 * hi; }
__device__ __forceinline__ bf16x8 pack8(const f32x16& p, int s) {
    v4u w; w.x = cvtpk(p[8 * s], p[8 * s + 1]); w.y = cvtpk(p[8 * s + 2], p[8 * s + 3]); w.z = cvtpk(p[8 * s + 4], p[8 * s + 5]); w.w = cvtpk(p[8 * s + 6], p[8 * s + 7]);
    return __builtin_bit_cast(bf16x8, w);
}
constexpr int KP = 72;
__device__ __forceinline__ v2u vtr(const LAS bf16* p) { return __builtin_bit_cast(v2u, __builtin_amdgcn_ds_read_tr16_b64_v4i16((LAS v4i16_t*)p)); }
__device__ __forceinline__ bf16x8 trfrag_perm(const LAS bf16* img, int kbase, int col0, int lane) {
    const LAS bf16* p = img + (kbase + 4 * (lane >> 5) + ((lane & 15) >> 2)) * KP + col0 + 16 * ((lane >> 4) & 1) + 4 * (lane & 3);
    const v2u lo = vtr(p), hi = vtr(p + 8 * KP); v4u w; w.x = lo.x; w.y = lo.y; w.z = hi.x; w.w = hi.y; return __builtin_bit_cast(bf16x8, w); }
__device__ __forceinline__ bf16x8 trfrag_nat(const LAS bf16* img, int kbase, int col0, int lane) {
    const LAS bf16* p = img + (kbase + 8 * (lane >> 5) + ((lane & 15) >> 2)) * KP + col0 + 16 * ((lane >> 4) & 1) + 4 * (lane & 3);
    const v2u lo = vtr(p), hi = vtr(p + 4 * KP); v4u w; w.x = lo.x; w.y = lo.y; w.z = hi.x; w.w = hi.y; return __builtin_bit_cast(bf16x8, w); }
__device__ __forceinline__ bf16x8 rowfrag(const LAS bf16* img, int row, int k0) { return *(const LAS bf16x8*)(img + row * KP + k0); }

__device__ __forceinline__ void store_row32(bf16* p, int hi, v2u w0, v2u w1, v2u w2, v2u w3) {
    { const auto rx = __builtin_amdgcn_permlane32_swap(w0.x, w1.x, false, false), ry = __builtin_amdgcn_permlane32_swap(w0.y, w1.y, false, false);
      v4u o; o.x = rx[0]; o.y = ry[0]; o.z = rx[1]; o.w = ry[1]; *(v4u*)(p + (hi ? 8 : 0)) = o; }
    { const auto rx = __builtin_amdgcn_permlane32_swap(w2.x, w3.x, false, false), ry = __builtin_amdgcn_permlane32_swap(w2.y, w3.y, false, false);
      v4u o; o.x = rx[0]; o.y = ry[0]; o.z = rx[1]; o.w = ry[1]; *(v4u*)(p + 16 + (hi ? 8 : 0)) = o; }
}

constexpr int M1_VS = 256 * KP * 2, M1_QS = 2 * M1_VS, M1_BT = M1_QS + 384 * KP * 2;
constexpr int PUP = 264;
constexpr int M1_UIMG = 128 * KP * 2;
static_assert(M1_BT + 3 * 192 * 4 <= MIX_BYTES && 6 * M1_UIMG <= MIX_BYTES, "mix1 LDS map");
__device__ __forceinline__ void mix1_fused(const Frame& F0, const Args& A, int layer) {
    const Frame F = phase_frame(F0);
    LAS bf16* KS = (LAS bf16*)(F.lds + RING_OFF);
    LAS bf16* VS = (LAS bf16*)(F.lds + RING_OFF + M1_VS);
    LAS bf16* QS = (LAS bf16*)(F.lds + RING_OFF + M1_QS);
    LAS float* BT = (LAS float*)(F.lds + RING_OFF + M1_BT);
    LAS bf16* UI = (LAS bf16*)(F.lds + RING_OFF);
    int tid_ = 0, lane = 0, l31 = 0, hi = 0;
#define OPAQUE_TID(k) do { int t_ = threadIdx.x; asm volatile("" : "+v"(t_)); tid_ = t_; lane = t_ & 63; l31 = t_ & 31; hi = (t_ >> 5) & 1; } while (0)
    const int vbid = (F.G % 8 == 0) ? (F.bid & 7) * (F.G >> 3) + (F.bid >> 3) : F.bid;
    for (int u = vbid; u < 256; u += F.G) {
        const int sel = u & 1, bn = u >> 1, b = bn >> 6, n = bn & 63;
        const int row0 = b * SEQ + n * 128;
        const int kt0 = (n == 0) ? 4 : 0;
        OPAQUE_TID(3);
        v4u kreg[4], vreg[4], qreg[6]; f32x2_t breg = {0.f, 0.f};
#pragma unroll
        for (int i = 0; i < 4; ++i) { const int item = tid_ + NTHR * i, key = item >> 3, c = item & 7; const bool ok = key >= kt0 * 32;
            const bf16* rp = P_Z + (size_t)(row0 - 128 + (ok ? key : 128)) * ZP + sel * 64 + 8 * c;
            kreg[i] = *(const v4u*)(rp + C_KA); vreg[i] = *(const v4u*)(rp + C_VA); }
#pragma unroll
        for (int i = 0; i < 6; ++i) { const int item = tid_ + NTHR * i, g = item >> 10, row = (item >> 3) & 127, c = item & 7;
            qreg[i] = *(const v4u*)(P_Z + (size_t)(row0 + row) * ZP + C_QA + (sel * 3 + g) * 64 + 8 * c); }
        if (tid_ < 288) breg = *(const f32x2_t*)(P_BIAST + sel * 576 + 2 * tid_);
        const float sk0 = A_SINKS[layer * 6 + sel * 3], sk1 = A_SINKS[layer * 6 + sel * 3 + 1], sk2 = A_SINKS[layer * 6 + sel * 3 + 2];
        OPAQUE_TID(1);
        {
            LAS bf16* PU = (LAS bf16*)(F.lds + RING_OFF);
            const int prow0 = row0 + 64 * sel - 15, t0 = (row0 + 64 * sel) & (SEQ - 1);
            v4u preg[5];
#pragma unroll
            for (int i = 0; i < 5; ++i) { const int item = tid_ + NTHR * i, r = item >> 5, c = item & 31; const bool ok = (item < 79 * 32) && (t0 - 15 + r >= 0);
                preg[i] = ok ? *(const v4u*)(P_Z + (size_t)(prow0 + r) * ZP + C_UP + 8 * c) : (v4u){0u, 0u, 0u, 0u}; }
            __syncthreads();
#pragma unroll
            for (int i = 0; i < 5; ++i) { const int item = tid_ + NTHR * i, r = item >> 5, c = item & 31; if (item < 79 * 32) *(LAS v4u*)(PU + r * PUP + 8 * c) = preg[i]; }
            __syncthreads();
            const int g = F.wave & 3, rt = F.wave >> 2, w = 2 << g;
            const int lrow = 15 + 32 * rt + l31, t = t0 + 32 * rt + l31;
            const float icnt = 1.0f / (float)(t + 1 < w ? t + 1 : w);
            f32x16 acc[2];
#pragma unroll
            for (int r = 0; r < 16; ++r) { acc[0][r] = 0.f; acc[1][r] = 0.f; }
#pragma unroll
            for (int ks = 0; ks < 4; ++ks) {
                const LAS bf16* up = PU + lrow * PUP + g * 64 + 16 * ks + 8 * hi;
                bf16x8 wf[2];
#pragma unroll
                for (int dh = 0; dh < 2; ++dh) wf[dh] = *(const bf16x8*)(P_PWT + ((size_t)(layer * 4 + g) * 64 + 32 * dh + l31) * 64 + 16 * ks + 8 * hi);
                float self[8], sum[8];
                { const v4u x = *(const LAS v4u*)up; self[0] = bflo(x.x); self[1] = bfhi(x.x); self[2] = bflo(x.y); self[3] = bfhi(x.y); self[4] = bflo(x.z); self[5] = bfhi(x.z); self[6] = bflo(x.w); self[7] = bfhi(x.w); }
#pragma unroll
                for (int e = 0; e < 8; ++e) sum[e] = 0.f;
                for (int k = 0; k < w; k += 2) { const v4u x = *(const LAS v4u*)(up - k * PUP), y2 = *(const LAS v4u*)(up - (k + 1) * PUP);
                    sum[0] += bflo(x.x) + bflo(y2.x); sum[1] += bfhi(x.x) + bfhi(y2.x); sum[2] += bflo(x.y) + bflo(y2.y); sum[3] += bfhi(x.y) + bfhi(y2.y);
                    sum[4] += bflo(x.z) + bflo(y2.z); sum[5] += bfhi(x.z) + bfhi(y2.z); sum[6] += bflo(x.w) + bflo(y2.w); sum[7] += bfhi(x.w) + bfhi(y2.w); }
                v4u pw_; pw_.x = cvtpk(sum[0] * icnt - self[0], sum[1] * icnt - self[1]); pw_.y = cvtpk(sum[2] * icnt - self[2], sum[3] * icnt - self[3]);
                pw_.z = cvtpk(sum[4] * icnt - self[4], sum[5] * icnt - self[5]); pw_.w = cvtpk(sum[6] * icnt - self[6], sum[7] * icnt - self[7]);
                const bf16x8 pf = __builtin_bit_cast(bf16x8, pw_);
#pragma unroll
                for (int dh = 0; dh < 2; ++dh) acc[dh] = __builtin_amdgcn_mfma_f32_32x32x16_bf16(wf[dh], pf, acc[dh], 0, 0, 0);
            }
            bf16* yp = P_Y + (size_t)(row0 + 64 * sel + 32 * rt + l31) * DM + Y_P + g * 64;
#pragma unroll
            for (int dh = 0; dh < 2; ++dh) { v2u o[4];
#pragma unroll
                for (int a = 0; a < 4; ++a) { o[a].x = cvtpk(acc[dh][4 * a], acc[dh][4 * a + 1]); o[a].y = cvtpk(acc[dh][4 * a + 2], acc[dh][4 * a + 3]); }
                store_row32(yp + 32 * dh, hi, o[0], o[1], o[2], o[3]); }
        }
        OPAQUE_TID(5);
        __syncthreads();
#pragma unroll
        for (int i = 0; i < 4; ++i) { const int item = tid_ + NTHR * i, key = item >> 3, c = item & 7; *(LAS v4u*)(KS + key * KP + 8 * c) = kreg[i]; *(LAS v4u*)(VS + key * KP + 8 * c) = vreg[i]; }
#pragma unroll
        for (int i = 0; i < 6; ++i) { const int item = tid_ + NTHR * i, g = item >> 10, row = (item >> 3) & 127, c = item & 7; *(LAS v4u*)(QS + (g * 128 + row) * KP + 8 * c) = qreg[i]; }
        if (tid_ < 288) *(LAS f32x2_t*)(BT + 2 * tid_) = breg;
        __syncthreads();
        OPAQUE_TID(6);
        for (int task = F.wave; task < 12; task += 8) {
            const int g = task >> 2, qb = task & 3, hq = sel * 3 + g;
            bf16x8 qf[4];
#pragma unroll
            for (int ks = 0; ks < 4; ++ks) qf[ks] = rowfrag(QS, g * 128 + 32 * qb + l31, 16 * ks + 8 * hi);
            f32x16 S[5];
#pragma unroll
            for (int kk = 0; kk < 5; ++kk) {
#pragma unroll
                for (int r = 0; r < 16; ++r) S[kk][r] = 0.f;
#pragma unroll
                for (int ks = 0; ks < 4; ++ks) S[kk] = __builtin_amdgcn_mfma_f32_32x32x16_bf16(rowfrag(KS, 32 * (qb + kk) + l31, 16 * ks + 8 * hi), qf[ks], S[kk], 0, 0, 0);
            }
#pragma unroll
            for (int kk = 0; kk < 5; ++kk) {
                const LAS float* bt = BT + g * 192 + 160 + l31 - 4 * hi - 32 * kk;
                float bv[16];
#pragma unroll
                for (int r = 0; r < 16; ++r) bv[r] = bt[-((r & 3) + 8 * (r >> 2))];
#pragma unroll
                for (int r = 0; r < 16; ++r) S[kk][r] += bv[r];
            }
            if (n == 0) {
#pragma unroll
                for (int kk = 0; kk < 5; ++kk)
#pragma unroll
                    for (int r = 0; r < 16; ++r) if (128 - crow(r, hi) - 32 * kk > 32 * qb) S[kk][r] = -1e30f;
            }
            float mx = -1e30f;
#pragma unroll
            for (int kk = 0; kk < 5; ++kk)
#pragma unroll
                for (int r = 0; r < 16; ++r) mx = fmaxf(mx, S[kk][r]);
            mx = fmaxf(mx, __shfl_xor(mx, 32));
            const float sk = g == 0 ? sk0 : (g == 1 ? sk1 : sk2); mx = fmaxf(mx, sk);
            float lsum = 0.f;
#pragma unroll
            for (int kk = 0; kk < 5; ++kk)
#pragma unroll
                for (int r = 0; r < 16; ++r) { const float p = __expf(S[kk][r] - mx); S[kk][r] = p; lsum += p; }
            lsum += __shfl_xor(lsum, 32); lsum += __expf(sk - mx);
            f32x16 O[2];
#pragma unroll
            for (int r = 0; r < 16; ++r) { O[0][r] = 0.f; O[1][r] = 0.f; }
#pragma unroll
            for (int kk = 0; kk < 5; ++kk)
#pragma unroll
                for (int s2 = 0; s2 < 2; ++s2) { const bf16x8 pf = pack8(S[kk], s2);
#pragma unroll
                    for (int dh = 0; dh < 2; ++dh) O[dh] = __builtin_amdgcn_mfma_f32_32x32x16_bf16(trfrag_perm(VS, 32 * (qb + kk) + 16 * s2, 32 * dh, lane), pf, O[dh], 0, 0, 0); }
            const float inv = __builtin_amdgcn_rcpf(lsum);
            bf16* yp = P_Y + (size_t)(row0 + 32 * qb + l31) * DM + Y_A + hq * 64;
#pragma unroll
            for (int dh = 0; dh < 2; ++dh) { v2u o[4];
#pragma unroll
                for (int a = 0; a < 4; ++a) { o[a].x = cvtpk(O[dh][4 * a] * inv, O[dh][4 * a + 1] * inv); o[a].y = cvtpk(O[dh][4 * a + 2] * inv, O[dh][4 * a + 3] * inv); }
                store_row32(yp + 32 * dh, hi, o[0], o[1], o[2], o[3]); }
        }
        OPAQUE_TID(0);
        v4u ureg[12];
#pragma unroll
        for (int i = 0; i < 12; ++i) { const int item = tid_ + NTHR * i, img = item >> 10, key = (item >> 3) & 127, c = item & 7;
            ureg[i] = *(const v4u*)(P_Z + (size_t)(row0 + key) * ZP + ((img & 1) ? C_VR : C_KR) + (3 * sel + (img >> 1)) * 64 + 8 * c); }
        OPAQUE_TID(2);
        __syncthreads();
#pragma unroll
        for (int i = 0; i < 12; ++i) { const int item = tid_ + NTHR * i, img = item >> 10, key = (item >> 3) & 127, c = item & 7; v4u w = ureg[i];
            if (img & 1) { const float zeta = __expf(ret_lg(3 * sel + (img >> 1)) * (float)(127 - key));
                w.x = cvtpk(bflo(w.x) * zeta, bfhi(w.x) * zeta); w.y = cvtpk(bflo(w.y) * zeta, bfhi(w.y) * zeta); w.z = cvtpk(bflo(w.z) * zeta, bfhi(w.z) * zeta); w.w = cvtpk(bflo(w.w) * zeta, bfhi(w.w) * zeta); }
            *(LAS v4u*)(UI + img * (128 * KP) + key * KP + 8 * c) = w; }
        __syncthreads();
        OPAQUE_TID(4);
        for (int task = F.wave; task < 12; task += 8) {
            const int hh = task >> 2, et = (task >> 1) & 1, dt = task & 1, h = 3 * sel + hh;
            const LAS bf16* kimg = UI + (2 * hh) * (128 * KP); const LAS bf16* vimg = UI + (2 * hh + 1) * (128 * KP);
            f32x16 acc;
#pragma unroll
            for (int r = 0; r < 16; ++r) acc[r] = 0.f;
#pragma unroll
            for (int ks = 0; ks < 8; ++ks) acc = __builtin_amdgcn_mfma_f32_32x32x16_bf16(trfrag_nat(vimg, 16 * ks, 32 * et, lane), trfrag_nat(kimg, 16 * ks, 32 * dt, lane), acc, 0, 0, 0);
            float* o = P_U + ((size_t)(b * 6 + h) * 64 + n) * 4096 + (32 * et) * 64 + 32 * dt + l31;
#pragma unroll
            for (int r = 0; r < 16; ++r) o[crow(r, hi) * 64] = acc[r];
        }
    }
}
#undef OPAQUE_TID

__device__ __forceinline__ void mix_scan_pair(const Frame& F0, const Args& A) {
    const Frame F = phase_frame(F0);
    const int NW_ = 12 * 4096 / 32;
    for (int wi = F.bid * NWAVES + F.wave; wi < NW_; wi += F.G * NWAVES) {
        const int chain = wi * 32 + (F.lane & 31), half = F.lane >> 5, bh = chain >> 12, de = chain & 4095, h = bh % 6;
        const float gch = __expf(ret_lg(h) * 128.0f);
        float* p = P_U + ((size_t)bh * 64 + 32 * half) * 4096 + de;
        float v[32];
#pragma unroll
        for (int k = 0; k < 32; ++k) v[k] = p[(size_t)k * 4096];
        float R = 0.f;
#pragma unroll
        for (int k = 0; k < 32; ++k) { const float u = v[k]; v[k] = R; R = R * gch + u; }
        const float carry = __shfl_xor(R, 32);
        float cf = half ? 1.0f : 0.0f;
#pragma unroll
        for (int k = 0; k < 32; ++k) { p[(size_t)k * 4096] = v[k] + cf * carry; cf *= gch; }
    }
}

constexpr int R3_VS = 384 * KP * 2, R3_RS = 2 * R3_VS, R3_DT = R3_RS + 192 * KP * 2;
static_assert(R3_DT + 3 * 160 * 4 <= MIX_BYTES, "retention-out LDS map");
__device__ __forceinline__ void mix_retout3(const Frame& F0, const Args& A) {
    const Frame F = phase_frame(F0);
    const int lane = F.lane, l31 = lane & 31, hi = lane >> 5;
    LAS bf16* KS = (LAS bf16*)(F.lds + RING_OFF);
    LAS bf16* VS = (LAS bf16*)(F.lds + RING_OFF + R3_VS);
    LAS bf16* RS = (LAS bf16*)(F.lds + RING_OFF + R3_RS);
    LAS float* DT = (LAS float*)(F.lds + RING_OFF + R3_DT);
    const int w = F.wave;
    const int nt = (w < 3 || w == 7) ? 1 : 2;
    const int th0 = w < 3 ? w : (w < 6 ? w - 3 : (w == 6 ? 0 : 2)), tq0 = w < 3 ? 3 : (w < 6 ? 2 : 1);
    const int th1 = w < 6 ? w - 3 : 1, tq1 = w < 6 ? 0 : 1;
    const int vbid = (F.G % 8 == 0) ? (F.bid & 7) * (F.G >> 3) + (F.bid >> 3) : F.bid;
    for (int u = vbid; u < 256; u += F.G) {
        const int hp = u & 1, bn = u >> 1, b = bn >> 6, n = bn & 63, row0 = b * SEQ + n * 128;
        v4u kreg[6], vreg[6]; f32x4 rreg[6]; bf16x8 qf[2][4]; v2u greg[2][8];
#pragma unroll
        for (int i = 0; i < 6; ++i) { const int item = F.tid + NTHR * i, hh = item >> 10, key = (item >> 3) & 127, c = item & 7;
            const bf16* rp = P_Z + (size_t)(row0 + key) * ZP + (3 * hp + hh) * 64 + 8 * c;
            kreg[i] = *(const v4u*)(rp + C_KR); vreg[i] = *(const v4u*)(rp + C_VR); }
#pragma unroll
        for (int i = 0; i < 6; ++i) { const int item = F.tid + NTHR * i, hh = item >> 10, e = (item >> 4) & 63, d4 = item & 15;
            rreg[i] = *(const f32x4*)(P_U + ((size_t)(b * 6 + 3 * hp + hh) * 64 + n) * 4096 + e * 64 + 4 * d4); }
#pragma unroll
        for (int ti = 0; ti < 2; ++ti) { const int th = ti ? th1 : th0, tq = ti ? tq1 : tq0, h = 3 * hp + th, rowq = row0 + 32 * tq + l31;
            if (ti < nt) {
                const bf16* qp = P_Z + (size_t)rowq * ZP + C_QR + h * 64 + 8 * hi;
#pragma unroll
                for (int ks = 0; ks < 4; ++ks) qf[ti][ks] = *(const bf16x8*)(qp + 16 * ks);
                const bf16* gp = P_Z + (size_t)rowq * ZP + C_GR + h * 64 + 4 * hi;
#pragma unroll
                for (int j = 0; j < 8; ++j) greg[ti][j] = *(const v2u*)(gp + 32 * (j >> 2) + 8 * (j & 3));
            } }
        __syncthreads();
#pragma unroll
        for (int i = 0; i < 6; ++i) { const int item = F.tid + NTHR * i, hh = item >> 10, key = (item >> 3) & 127, c = item & 7;
            *(LAS v4u*)(KS + (hh * 128 + key) * KP + 8 * c) = kreg[i]; *(LAS v4u*)(VS + (hh * 128 + key) * KP + 8 * c) = vreg[i]; }
#pragma unroll
        for (int i = 0; i < 6; ++i) { const int item = F.tid + NTHR * i, hh = item >> 10, e = (item >> 4) & 63, d4 = item & 15;
            v2u w2; w2.x = cvtpk(rreg[i][0], rreg[i][1]); w2.y = cvtpk(rreg[i][2], rreg[i][3]); *(LAS v2u*)(RS + (hh * 64 + e) * KP + 4 * d4) = w2; }
        { const float lg0 = ret_lg(3 * hp), lg1 = ret_lg(3 * hp + 1), lg2 = ret_lg(3 * hp + 2);
          for (int e = F.tid; e < 3 * 160; e += NTHR) { const int hh = e / 160, diff = e % 160 - 32; const float lgv = hh == 0 ? lg0 : (hh == 1 ? lg1 : lg2); DT[e] = diff >= 0 ? __expf(lgv * (float)diff) : 0.f; } }
        __syncthreads();
#pragma unroll
        for (int ti = 0; ti < 2; ++ti) {
            if (ti < nt) {
                const int hh = ti ? th1 : th0, qb = ti ? tq1 : tq0, h = 3 * hp + hh, rowq = row0 + 32 * qb + l31; const float lg = ret_lg(h);
                f32x16 O[2], C[2];
#pragma unroll
                for (int r = 0; r < 16; ++r) { O[0][r] = 0.f; O[1][r] = 0.f; C[0][r] = 0.f; C[1][r] = 0.f; }
#pragma unroll
                for (int eh = 0; eh < 2; ++eh)
#pragma unroll
                    for (int ks = 0; ks < 4; ++ks) C[eh] = __builtin_amdgcn_mfma_f32_32x32x16_bf16(rowfrag(RS, hh * 64 + 32 * eh + l31, 16 * ks + 8 * hi), qf[ti][ks], C[eh], 0, 0, 0);
                for (int kt = 0; kt <= qb; ++kt) {
                    f32x16 S;
#pragma unroll
                    for (int r = 0; r < 16; ++r) S[r] = 0.f;
#pragma unroll
                    for (int ks = 0; ks < 4; ++ks) S = __builtin_amdgcn_mfma_f32_32x32x16_bf16(rowfrag(KS, hh * 128 + 32 * kt + l31, 16 * ks + 8 * hi), qf[ti][ks], S, 0, 0, 0);
                    const int dbase = 32 * (qb - kt) + l31 + 32;
#pragma unroll
                    for (int r = 0; r < 16; ++r) S[r] *= DT[hh * 160 + dbase - crow(r, hi)];
#pragma unroll
                    for (int s2 = 0; s2 < 2; ++s2) { const bf16x8 pf = pack8(S, s2);
#pragma unroll
                        for (int eh = 0; eh < 2; ++eh) O[eh] = __builtin_amdgcn_mfma_f32_32x32x16_bf16(trfrag_perm(VS + hh * (128 * KP), 32 * kt + 16 * s2, 32 * eh, lane), pf, O[eh], 0, 0, 0); }
                }
                const float xi = __expf(lg * (float)(32 * qb + l31 + 1));
                float ms = 0.f;
#pragma unroll
                for (int eh = 0; eh < 2; ++eh)
#pragma unroll
                    for (int r = 0; r < 16; ++r) { const float o = O[eh][r] + xi * C[eh][r]; O[eh][r] = o; ms += o * o; }
                ms += __shfl_xor(ms, 32);
                const float rn = __builtin_amdgcn_rsqf(ms * (1.0f / 64.0f) + 1e-6f);
                bf16* yp = P_Y + (size_t)rowq * DM + Y_R + h * 64;
#pragma unroll
                for (int eh = 0; eh < 2; ++eh) { v2u o[4];
#pragma unroll
                    for (int a = 0; a < 4; ++a) { const v2u gw = greg[ti][eh * 4 + a];
                        const float g0 = bflo(gw.x), g1 = bfhi(gw.x), g2 = bflo(gw.y), g3 = bfhi(gw.y);
                        const float o0 = g0 * __builtin_amdgcn_rcpf(1.0f + __expf(-g0)) * O[eh][4 * a] * rn, o1 = g1 * __builtin_amdgcn_rcpf(1.0f + __expf(-g1)) * O[eh][4 * a + 1] * rn;
                        const float o2 = g2 * __builtin_amdgcn_rcpf(1.0f + __expf(-g2)) * O[eh][4 * a + 2] * rn, o3 = g3 * __builtin_amdgcn_rcpf(1.0f + __expf(-g3)) * O[eh][4 * a + 3] * rn;
                        o[a].x = cvtpk(o0, o1); o[a].y = cvtpk(o2, o3); }
                    store_row32(yp + 32 * eh, hi, o[0], o[1], o[2], o[3]); }
            }
        }
    }
}
__device__ __forceinline__ void final_norm(const Frame& F0, const Args& A) {
    const Frame F = phase_frame(F0);
    const int gw = F.bid * NWAVES + F.wave, NGW = F.G * NWAVES;
    for (int m = gw; m < MROWS; m += NGW) {
        const GAS v4u* xr = (const GAS v4u*)(P_XB + (size_t)m * DM) + F.lane; float v[16]; float s = 0.f;
#pragma unroll
        for (int j = 0; j < 2; ++j) { const v4u w = xr[64 * j];
            v[8 * j] = bflo(w.x); v[8 * j + 1] = bfhi(w.x); v[8 * j + 2] = bflo(w.y); v[8 * j + 3] = bfhi(w.y); v[8 * j + 4] = bflo(w.z); v[8 * j + 5] = bfhi(w.z); v[8 * j + 6] = bflo(w.w); v[8 * j + 7] = bfhi(w.w); }
#pragma unroll
        for (int e = 0; e < 16; ++e) s += v[e] * v[e];
        const float rs = 1.0f / sqrtf(wave_sum(s) * (1.0f / DM) + 1e-6f);
        GAS f32x4* o = (GAS f32x4*)(A.out + (size_t)m * DM);
#pragma unroll
        for (int j = 0; j < 2; ++j) { const int c0 = 512 * j + 8 * F.lane; const f32x4 g0 = *(const GAS f32x4*)(A_FINAL_G + c0), g1 = *(const GAS f32x4*)(A_FINAL_G + c0 + 4);
            o[c0 / 4] = (f32x4){v[8 * j] * rs * g0.x, v[8 * j + 1] * rs * g0.y, v[8 * j + 2] * rs * g0.z, v[8 * j + 3] * rs * g0.w};
            o[c0 / 4 + 1] = (f32x4){v[8 * j + 4] * rs * g1.x, v[8 * j + 5] * rs * g1.y, v[8 * j + 6] * rs * g1.z, v[8 * j + 7] * rs * g1.w}; }
    }
}

__global__ void __launch_bounds__(NTHR, 2) mk_fwd(Args args) {
    extern __shared__ __attribute__((aligned(16))) unsigned char lds[];
    const Args& A = args;
    Frame F;
    F.lds = (LAS unsigned char*)lds;
    F.tid = threadIdx.x; F.lane = F.tid & 63; F.wave = __builtin_amdgcn_readfirstlane(F.tid >> 6); F.G = gridDim.x; F.bid = blockIdx.x; F.ws = (GAS unsigned char*)args.ws;
    for (int u = F.tid; u < (LDS_BYTES - LDSCTL_OFF) / 4; u += NTHR) ((LAS unsigned*)(F.lds + LDSCTL_OFF))[u] = 0u;
    __syncthreads();
    const int lo = args.ph_lo, hi = args.ph_hi;
    XcdBarrier bar; bar.bar = (unsigned*)(F.ws + WS_CTL) + CW_BAR; bar.x = 0; bar.st = nullptr;
    if (hi - lo > 1) bar = xcd_barrier_post((unsigned*)(F.ws + WS_CTL) + CW_BAR, (volatile LAS unsigned*)(F.lds + MISC_OFF) + 8);

    if (lo == 0) { p0_prologue(F, A); if (hi > 1) xcd_barrier(bar); }
    for (int ph = (lo == 0 ? 1 : lo); ph < hi; ++ph) {
        if (ph == NPHASE - 1) break;
        if (ph != 0 && ph != NPHASE - 1) {
            const int layer = (ph - 1) / 7, s = (ph - 1) % 7;
            if (s == 0) {
                pg8::Gemm g{P_XB, wptr(F, layer, W_IN), MROWS, ZP, DM}; pg8::PanelOrder S; S.init(MROWS, ZP, F.G, F.bid);
                LAS float* rtab = (LAS float*)(F.lds + RING_BYTES);
                pg8::EpiIn E{P_Z, ZP, rtab, P_ROPE, P_SSQ};
                pg8::gemm_phase<pg8::EpiIn, pg8::PanelOrder, true, true>(F.lds + RING_OFF, g, S, E);
                if (CONV_AHEAD && layer + 1 < DEPTH) {
                    const int nwg = (MROWS / 256) * (ZP / 256), nmax = (nwg + F.G - 1) / F.G; pg8::Unit ul; const bool busy = S.next(nmax - 1, ul);
                    const int nlast = (ZP / 256) - 4 * (nmax - 1);
                    if ((F.G & 3) == 0 && nlast > 0 && nlast < 4) { if (!busy) { __syncthreads(); const Frame Fc = phase_frame(F); const int nid = 4 - nlast;
                            convert_weights(Fc, A, layer + 1, layer + 2, ((S.vc >> 2) * nid + (S.vc & 3) - nlast) * NWAVES + Fc.wave, (F.G >> 2) * nid * NWAVES); } }
                    else { __syncthreads(); const Frame Fc = phase_frame(F); convert_weights(Fc, A, layer + 1, layer + 2, F.bid * NWAVES + Fc.wave, F.G * NWAVES); }
                }
            } else if (s == 1) {
                mix1_fused(F, A, layer);
            } else if (s == 2) {
                mix_scan_pair(F, A);
            } else if (s == 3) {
                mix_retout3(F, A);
            } else if (s == 4 || s == 6) {
                const bool dn = (s == 6);
                pg8::Gemm g{dn ? P_H : P_Y, wptr(F, layer, dn ? W_DN : W_OUT), MROWS, DM, dn ? FF : DM}; pg8::StaticOrder S; S.init(MROWS, DM, F.G, F.bid);
                pg8::EpiRes E{P_XB, P_SSQ};
                pg8::gemm_phase<pg8::EpiRes, pg8::StaticOrder, true, true>(F.lds + RING_OFF, g, S, E);
            } else {
                pg8::Gemm g{P_XB, wptr(F, layer, W_UP), MROWS, FF, DM}; pg8::StaticOrder S; S.init(MROWS, FF, F.G, F.bid);
                LAS float* rtab = (LAS float*)(F.lds + RING_BYTES);
                pg8::EpiUp E{P_H, FF, rtab, P_SSQ};
                pg8::gemm_phase<pg8::EpiUp, pg8::StaticOrder, true, true>(F.lds + RING_OFF, g, S, E);
            }
        }
        if (ph + 1 < hi) xcd_barrier(bar);
    }
    if (hi == NPHASE) final_norm(F, A);
}

#ifndef MK_ONE_LAUNCH
#define MK_ONE_LAUNCH 1
#endif
extern "C" void kernel_launch(void* const* d_in, const int* in_sizes, int n_in, void* d_out, int out_size, void* d_ws, size_t ws_size, hipStream_t stream) {
    static int grid = 0;
    if (grid == 0) {
        if (n_in != 12 || in_sizes[0] != MROWS * DM || out_size != MROWS * DM || ws_size < WS_END) { fprintf(stderr, "kernel_launch: unexpected shapes (n_in %d, in0 %d, out %d, ws %zu); nothing launched\n", n_in, n_in > 0 ? in_sizes[0] : -1, out_size, ws_size); grid = -1; return; }
        int dev = 0, cus = 0, per_cu = 0;
        if (hipGetDevice(&dev) != hipSuccess || hipDeviceGetAttribute(&cus, hipDeviceAttributeMultiprocessorCount, dev) != hipSuccess) { grid = -1; return; }
        if (hipFuncSetAttribute((const void*)mk_fwd, hipFuncAttributeMaxDynamicSharedMemorySize, LDS_BYTES) != hipSuccess) { fprintf(stderr, "kernel_launch: hipFuncSetAttribute failed\n"); grid = -1; return; }
        if (hipOccupancyMaxActiveBlocksPerMultiprocessor(&per_cu, (const void*)mk_fwd, NTHR, LDS_BYTES) != hipSuccess || per_cu < 1) { fprintf(stderr, "kernel_launch: occupancy query says %d blocks per CU\n", per_cu); per_cu = 1; }
        (void)hipGetLastError();
        grid = cus;
    }
    if (grid < 0) return;
    (void)hipMemsetAsync((char*)d_ws + WS_CTL, 0, CTL_ZERO_BYTES, stream);
    Args a{};
    for (int i = 0; i < 12; ++i) a.in[i] = (const float*)d_in[i];
    a.out = (float*)d_out; a.ws = (unsigned char*)d_ws;
#if MK_ONE_LAUNCH
    a.ph_lo = 0; a.ph_hi = NPHASE;
    hipLaunchKernelGGL(mk_fwd, dim3(grid), dim3(NTHR), LDS_BYTES, stream, a);
#else
    for (int ph = 0; ph < NPHASE; ++ph) { a.ph_lo = ph; a.ph_hi = ph + 1; hipLaunchKernelGGL(mk_fwd, dim3(grid), dim3(NTHR), LDS_BYTES, stream, a); }
#endif
}
```

```cpp
#include <hip/hip_runtime.h>
#include <cstdio>
#include <cstdint>
namespace pg8 {
#define PG8_LAS __attribute__((address_space(3)))
typedef unsigned short bf16_t;
typedef short bf16x8 __attribute__((ext_vector_type(8)));
typedef float f32x4 __attribute__((ext_vector_type(4)));
typedef unsigned u32x4 __attribute__((ext_vector_type(4)));
constexpr int BM = 256, BK = 64, HALF = 128, HTB = HALF * BK * 2  , STAGE_BYTES = 8 * HTB, NXCD = 8, WGM = 4;

__host__ __device__ __forceinline__ int lds_byte(int r, int c) { const int st = (r >> 4) * 2 + (c >> 5), rr = r & 15, cc = c & 31, ob = rr * 64 + cc * 2; return st * 1024 + (ob ^ (((ob >> 9) & 1) << 5)); }
__host__ __device__ __forceinline__ void stage_rc(int b, int& R, int& C) { const int st = b / 1024, sb = b % 1024, swz = sb ^ (((sb >> 9) & 1) << 5); R = (st >> 1) * 16 + swz / 64; C = (st & 1) * 32 + (swz % 64) / 2; }
__host__ __device__ __forceinline__ int perm32(int rho) { const int n = rho >> 4, i = rho & 15; return 8 * (i >> 2) + 4 * n + (i & 3); }

struct Unit { int pm, pn; };
struct Gemm { const bf16_t* A; const bf16_t* Bt; int M, N, K; };

struct StaticOrder {
    int nM, nN, nwg, G, c;
    __host__ __device__ void init(int M, int N, int G_, int c_) { nM = M / BM; nN = N / BM; nwg = nM * nN; G = G_; c = c_; }
    __host__ __device__ bool next(int i, Unit& u) const {
        const long L = (long)i * G + c; if (L >= nwg) return false;
        int wgid = (int)L; { const int q = nwg / NXCD, r = nwg % NXCD, xcd = wgid % NXCD, off = wgid / NXCD; wgid = (xcd < r ? xcd * (q + 1) : r * (q + 1) + (xcd - r) * q) + off; }
        const int nig = WGM * nN, gid = wgid / nig, fm = gid * WGM, gsz = (nM - fm) < WGM ? (nM - fm) : WGM;
        u.pm = fm + ((wgid % nig) % gsz); u.pn = (wgid % nig) / gsz; return true;
    }
    __device__ __forceinline__ void a_ready(const Unit&) const {}
    __device__ __forceinline__ void done(const Unit&) const {}
};

struct PanelOrder {
    int nM, nN, G, vc;
    __host__ __device__ void init(int M, int N, int G_, int bid) { nM = M / BM; nN = N / BM; G = G_; vc = (G_ % 8 == 0) ? (bid & 7) * (G_ >> 3) + (bid >> 3) : bid; }
    __host__ __device__ bool next(int i, Unit& u) const {
        if (G & 3) { const long L = (long)i * G + vc; if (L >= (long)nM * nN) return false; u.pm = (int)(L / nN); u.pn = (int)(L % nN); return true; }
        const int pr = i * (G >> 2) + (vc >> 2), ip = pr / nM; u.pm = pr % nM; u.pn = (vc & 3) + 4 * ip; return u.pn < nN;
    }
    __device__ __forceinline__ void a_ready(const Unit&) const {}
    __device__ __forceinline__ void done(const Unit&) const {}
};

__device__ __forceinline__ unsigned cvt_pk_bf16(float lo, float hi) { unsigned r; asm volatile("v_cvt_pk_bf16_f32 %0, %1, %2" : "=v"(r) : "v"(lo), "v"(hi)); return r; }
typedef unsigned u32x2 __attribute__((ext_vector_type(2)));

__device__ __forceinline__ float row_rstd(const float* ssq, int row) {
    const f32x4* p = (const f32x4*)(ssq + (size_t)row * 16);
    const f32x4 a = p[0], b = p[1], c = p[2], d = p[3];
    const float s = ((a[0] + a[1]) + (a[2] + a[3])) + ((b[0] + b[1]) + (b[2] + b[3])) + ((c[0] + c[1]) + (c[2] + c[3])) + ((d[0] + d[1]) + (d[2] + d[3]));
    return __builtin_amdgcn_rsqf(s * (1.0f / 1024.0f) + 1e-6f);
}

template <class Sched> __device__ __forceinline__ void rstd_table(PG8_LAS float* tab, const float* ssq, const Sched& S) {
    int tid_ = threadIdx.x; asm volatile("" : "+v"(tid_));
    const int t = tid_ & 255, half = __builtin_amdgcn_readfirstlane(tid_ >> 8);
    f32x4 v[4][4]; bool ok[4];
#pragma unroll
    for (int j = 0; j < 4; ++j) { Unit u; ok[j] = S.next(half + 2 * j, u);
        if (ok[j]) { const f32x4* p = (const f32x4*)(ssq + (size_t)(u.pm * BM + t) * 16); v[j][0] = p[0]; v[j][1] = p[1]; v[j][2] = p[2]; v[j][3] = p[3]; } }
#pragma unroll
    for (int j = 0; j < 4; ++j) if (ok[j]) { const f32x4 a = v[j][0], b = v[j][1], c = v[j][2], d = v[j][3];
        const float s = ((a[0] + a[1]) + (a[2] + a[3])) + ((b[0] + b[1]) + (b[2] + b[3])) + ((c[0] + c[1]) + (c[2] + c[3])) + ((d[0] + d[1]) + (d[2] + d[3]));
        tab[(half + 2 * j) * 256 + t] = __builtin_amdgcn_rsqf(s * (1.0f / 1024.0f) + 1e-6f); }
    __syncthreads();
}

struct EpiIn {
    static constexpr bool PERM = true, ADJ = false, AFTER_DRAIN = false;
    bf16_t* Z; int ldz; PG8_LAS float* rstd; const float* rope; const float* ssq;
    template <class Sched> __device__ __forceinline__ void after_first_stage(const Sched& S) const { rstd_table(rstd, ssq, S); }
    __device__ __forceinline__ void operator()(const f32x4 (&acc)[2][2][4][2], const Unit& u, int wr, int wc, int fr, int fq, int ui) const {
        const int row0 = u.pm * BM + wr * 64 + fr, col0 = u.pn * BM + wc * 32 + 8 * fq;
        const bool rot0 = (2 * u.pn >= 5 && 2 * u.pn < 11), rot1 = (2 * u.pn + 1 >= 5 && 2 * u.pn + 1 < 11);
        if (rot0 || rot1) {
            const int i0 = ((wc * 32 + 8 * fq) & 63) >> 1;
            f32x4 cs[4][2]; u32x4 w[2][4][2];
#define PG8_IN_LOAD(ai) do { _Pragma("unroll") for (int m = 0; m < 4; ++m) { const f32x4* rp = (const f32x4*)(rope + ((size_t)((row0 + (ai) * HALF + m * 16) & 8191) * 32 + i0) * 2); cs[m][0] = rp[0]; cs[m][1] = rp[1]; } } while (0)
#define PG8_IN_COMP(ai) do { _Pragma("unroll") for (int m = 0; m < 4; ++m) { const float rs = rstd[ui * 256 + wr * 64 + fr + (ai) * HALF + m * 16]; const f32x4 c01 = cs[m][0], c23 = cs[m][1]; \
            _Pragma("unroll") for (int bj = 0; bj < 2; ++bj) { f32x4 v0 = acc[ai][bj][m][0] * rs, v1 = acc[ai][bj][m][1] * rs; \
                if (bj ? rot1 : rot0) { f32x4 w0, w1; \
                    w0[0] = v0[0] * c01[0] - v0[1] * c01[1]; w0[1] = v0[0] * c01[1] + v0[1] * c01[0]; w0[2] = v0[2] * c01[2] - v0[3] * c01[3]; w0[3] = v0[2] * c01[3] + v0[3] * c01[2]; \
                    w1[0] = v1[0] * c23[0] - v1[1] * c23[1]; w1[1] = v1[0] * c23[1] + v1[1] * c23[0]; w1[2] = v1[2] * c23[2] - v1[3] * c23[3]; w1[3] = v1[2] * c23[3] + v1[3] * c23[2]; v0 = w0; v1 = w1; } \
                u32x4 o; o.x = cvt_pk_bf16(v0[0], v0[1]); o.y = cvt_pk_bf16(v0[2], v0[3]); o.z = cvt_pk_bf16(v1[0], v1[1]); o.w = cvt_pk_bf16(v1[2], v1[3]); w[ai][m][bj] = o; } } } while (0)
#define PG8_IN_STORE(ai) do { _Pragma("unroll") for (int m = 0; m < 4; ++m) _Pragma("unroll") for (int bj = 0; bj < 2; ++bj) *(u32x4*)(Z + (size_t)(row0 + (ai) * HALF + m * 16) * ldz + col0 + bj * HALF) = w[ai][m][bj]; } while (0)
            PG8_IN_LOAD(0); PG8_IN_COMP(0); PG8_IN_LOAD(1); PG8_IN_STORE(0); PG8_IN_COMP(1); PG8_IN_STORE(1);
#undef PG8_IN_LOAD
#undef PG8_IN_COMP
#undef PG8_IN_STORE
        } else {
#pragma unroll
            for (int ai = 0; ai < 2; ++ai)
#pragma unroll
                for (int m = 0; m < 4; ++m) {
                    const int row = row0 + ai * HALF + m * 16; const float rs = rstd[ui * 256 + wr * 64 + fr + ai * HALF + m * 16];
#pragma unroll
                    for (int bj = 0; bj < 2; ++bj) {
                        const f32x4 v0 = acc[ai][bj][m][0] * rs, v1 = acc[ai][bj][m][1] * rs;
                        u32x4 w; w.x = cvt_pk_bf16(v0[0], v0[1]); w.y = cvt_pk_bf16(v0[2], v0[3]); w.z = cvt_pk_bf16(v1[0], v1[1]); w.w = cvt_pk_bf16(v1[2], v1[3]);
                        *(u32x4*)(Z + (size_t)row * ldz + col0 + bj * HALF) = w;
                    }
                }
        }
    }
};

struct EpiUp {
    static constexpr bool PERM = true, ADJ = true, AFTER_DRAIN = false;
    bf16_t* H; int ldh; PG8_LAS float* rstd; const float* ssq;
    template <class Sched> __device__ __forceinline__ void after_first_stage(const Sched& S) const { rstd_table(rstd, ssq, S); }
    __device__ __forceinline__ void operator()(const f32x4 (&acc)[2][2][4][2], const Unit& u, int wr, int wc, int fr, int fq, int ui) const {
        const int row0 = u.pm * BM + wr * 64 + fr, col0 = u.pn * BM + wc * 64 + 8 * fq;
#pragma unroll
        for (int ai = 0; ai < 2; ++ai)
#pragma unroll
            for (int m = 0; m < 4; ++m) {
                const int row = row0 + ai * HALF + m * 16; const float rs = rstd[ui * 256 + wr * 64 + fr + ai * HALF + m * 16];
#pragma unroll
                for (int bj = 0; bj < 2; ++bj) {
                    f32x4 v0 = acc[ai][bj][m][0] * rs, v1 = acc[ai][bj][m][1] * rs;
#pragma unroll
                    for (int e = 0; e < 4; ++e) { const float a = fmaxf(v0[e], 0.f), b = fmaxf(v1[e], 0.f); v0[e] = a * a; v1[e] = b * b; }
                    u32x4 w; w.x = cvt_pk_bf16(v0[0], v0[1]); w.y = cvt_pk_bf16(v0[2], v0[3]); w.z = cvt_pk_bf16(v1[0], v1[1]); w.w = cvt_pk_bf16(v1[2], v1[3]);
                    *(u32x4*)(H + (size_t)row * ldh + col0 + bj * 32) = w;
                }
            }
    }
};

struct EpiRes {
    static constexpr bool PERM = true, ADJ = true, AFTER_DRAIN = false;
    bf16_t* xb; float* ssq;
    template <class Sched> __device__ __forceinline__ void after_first_stage(const Sched&) const {}
    __device__ __forceinline__ void operator()(const f32x4 (&acc)[2][2][4][2], const Unit& u, int wr, int wc, int fr, int fq, int) const {
        const int row0 = u.pm * BM + wr * 64 + fr, col0 = u.pn * BM + wc * 64 + 8 * fq;
        u32x4 bv[4][2], w[2][4][2]; float sq[2][4];
#define PG8_RES_LOAD(ai) do { _Pragma("unroll") for (int m = 0; m < 4; ++m) _Pragma("unroll") for (int bj = 0; bj < 2; ++bj) bv[m][bj] = *(const u32x4*)(xb + (size_t)(row0 + (ai) * HALF + m * 16) * 1024 + col0 + bj * 32); } while (0)
#define PG8_RES_COMP(ai) do { _Pragma("unroll") for (int m = 0; m < 4; ++m) { float s = 0.f; _Pragma("unroll") for (int bj = 0; bj < 2; ++bj) { const u32x4 b = bv[m][bj]; f32x4 x0, x1; \
            x0[0] = __uint_as_float(b.x << 16) + acc[ai][bj][m][0][0]; x0[1] = __uint_as_float(b.x & 0xffff0000u) + acc[ai][bj][m][0][1]; \
            x0[2] = __uint_as_float(b.y << 16) + acc[ai][bj][m][0][2]; x0[3] = __uint_as_float(b.y & 0xffff0000u) + acc[ai][bj][m][0][3]; \
            x1[0] = __uint_as_float(b.z << 16) + acc[ai][bj][m][1][0]; x1[1] = __uint_as_float(b.z & 0xffff0000u) + acc[ai][bj][m][1][1]; \
            x1[2] = __uint_as_float(b.w << 16) + acc[ai][bj][m][1][2]; x1[3] = __uint_as_float(b.w & 0xffff0000u) + acc[ai][bj][m][1][3]; \
            u32x4 o; o.x = cvt_pk_bf16(x0[0], x0[1]); o.y = cvt_pk_bf16(x0[2], x0[3]); o.z = cvt_pk_bf16(x1[0], x1[1]); o.w = cvt_pk_bf16(x1[2], x1[3]); w[ai][m][bj] = o; \
            s += ((x0[0] * x0[0] + x0[1] * x0[1]) + (x0[2] * x0[2] + x0[3] * x0[3])) + ((x1[0] * x1[0] + x1[1] * x1[1]) + (x1[2] * x1[2] + x1[3] * x1[3])); } \
            s += __shfl_xor(s, 16); s += __shfl_xor(s, 32); sq[ai][m] = s; } } while (0)
#define PG8_RES_STORE(ai) do { _Pragma("unroll") for (int m = 0; m < 4; ++m) { const int row = row0 + (ai) * HALF + m * 16; _Pragma("unroll") for (int bj = 0; bj < 2; ++bj) *(u32x4*)(xb + (size_t)row * 1024 + col0 + bj * 32) = w[ai][m][bj]; \
            if (fq == 0) ssq[(size_t)row * 16 + u.pn * 4 + wc] = sq[ai][m]; } } while (0)
        PG8_RES_LOAD(0); PG8_RES_COMP(0); PG8_RES_LOAD(1); PG8_RES_STORE(0); PG8_RES_COMP(1); PG8_RES_STORE(1);
#undef PG8_RES_LOAD
#undef PG8_RES_COMP
#undef PG8_RES_STORE
    }
};

template <class Epi, class Sched, bool ALIGN_EPI = false, bool SP2 = false>
__device__ __forceinline__ void gemm_phase(PG8_LAS unsigned char* lds, const Gemm g, const Sched& S, const Epi& E) {
    int tid_ = threadIdx.x; asm volatile("" : "+v"(tid_));
    const int tid = tid_, wid = __builtin_amdgcn_readfirstlane(tid >> 6), lane = tid & 63, wr = wid >> 2, wc = wid & 3, fr = lane & 15, fq = lane >> 4;
    const int K = g.K, nt = K / BK;
    unsigned voffA[2], voffB[2];
#pragma unroll
    for (int i = 0; i < 2; ++i) { int R, C; stage_rc(tid * 16 + i * 8192, R, C); const int Rb = Epi::PERM ? ((Epi::ADJ ? ((R >> 5) << 6) : (R & ~31)) + perm32(R & 31)) : R;
        voffA[i] = (unsigned)(R * K + C) * 2u; voffB[i] = (unsigned)(Rb * K + C) * 2u; }
    const size_t kstep = (size_t)(BK * 2);
    const size_t hstep = (size_t)HALF * K * 2;
    const size_t tstep = 2 * hstep;
    const size_t bhstep = Epi::ADJ ? (size_t)32 * K * 2 : hstep;
    const unsigned ldsw = (unsigned)wid * 1024u;
    const int aoff = lds_byte(wr * 64 + fr, fq * 8), boff = lds_byte(wc * 32 + fr, fq * 8);
#define PG8_SA(b, h) (((b) * 2 + (h)) * HTB)
#define PG8_SB(b, h) ((4 + (b) * 2 + (h)) * HTB)
#define PG8_STAGE(bufoff, gbase, voff) do { _Pragma("unroll") for (int _i = 0; _i < 2; ++_i) \
        __builtin_amdgcn_global_load_lds((const unsigned*)((const char*)(gbase) + (voff)[_i]), (PG8_LAS unsigned*)(lds + (bufoff) + ldsw + _i * 8192), 16, 0, 0); } while (0)
#define PG8_LDA(dst, b, h) do { _Pragma("unroll") for (int m = 0; m < 4; ++m) _Pragma("unroll") for (int k = 0; k < 2; ++k) dst[m][k] = *(const PG8_LAS bf16x8*)(lds + PG8_SA(b, h) + aoff + m * 2048 + k * 1024); } while (0)
#define PG8_LDB(dst, b, h) do { _Pragma("unroll") for (int n = 0; n < 2; ++n) _Pragma("unroll") for (int k = 0; k < 2; ++k) dst[n][k] = *(const PG8_LAS bf16x8*)(lds + PG8_SB(b, h) + boff + n * 2048 + k * 1024); } while (0)
#define PG8_MMA(ai, bj, At, Bt) do { __builtin_amdgcn_s_setprio(1); _Pragma("unroll") for (int m = 0; m < 4; ++m) _Pragma("unroll") for (int n = 0; n < 2; ++n) _Pragma("unroll") for (int k = 0; k < 2; ++k) \
        acc[ai][bj][m][n] = __builtin_amdgcn_mfma_f32_16x16x32_bf16(Bt[n][k], At[m][k], acc[ai][bj][m][n], 0, 0, 0); __builtin_amdgcn_s_setprio(0); } while (0)
#define PG8_WAIT_V(n) asm volatile("s_waitcnt vmcnt(" #n ")" ::: "memory")
#define PG8_WAIT_L(n) asm volatile("s_waitcnt lgkmcnt(" #n ")" ::: "memory")
#define PG8_BAR __builtin_amdgcn_s_barrier()
#define PG8_SCHED __builtin_amdgcn_sched_barrier(0)
    Unit cur, nxt; int ui = 0;
    if (!S.next(0, cur)) return;
    f32x4 acc[2][2][4][2];
#pragma unroll
    for (int a = 0; a < 2; ++a)
#pragma unroll
        for (int b = 0; b < 2; ++b)
#pragma unroll
            for (int m = 0; m < 4; ++m)
#pragma unroll
                for (int n = 0; n < 2; ++n) acc[a][b][m][n] = (f32x4){0.f, 0.f, 0.f, 0.f};
    bf16x8 At[4][2], B0[2][2], B1[2][2];
    const char* cA = (const char*)g.A + (size_t)cur.pm * tstep; const char* cB = (const char*)g.Bt + (size_t)cur.pn * tstep;
    S.a_ready(cur);
    if constexpr (SP2) {
        PG8_STAGE(PG8_SB(0, 0), cB, voffB); PG8_STAGE(PG8_SB(0, 1), cB + bhstep, voffB); PG8_STAGE(PG8_SA(0, 0), cA, voffA); PG8_STAGE(PG8_SA(0, 1), cA + hstep, voffA);
        E.after_first_stage(S);
        if (wr == 1) PG8_BAR;
        PG8_WAIT_V(2); PG8_BAR;
        PG8_STAGE(PG8_SB(1, 0), cB + kstep, voffB); PG8_STAGE(PG8_SA(1, 0), cA + kstep, voffA); PG8_STAGE(PG8_SB(1, 1), cB + bhstep + kstep, voffB);
        PG8_WAIT_V(6); PG8_BAR;
    } else {
        PG8_STAGE(PG8_SB(0, 0), cB, voffB); PG8_STAGE(PG8_SA(0, 0), cA, voffA); PG8_STAGE(PG8_SB(0, 1), cB + bhstep, voffB); PG8_STAGE(PG8_SA(0, 1), cA + hstep, voffA);
        if (wr == 1) PG8_BAR;
        PG8_WAIT_V(4); PG8_BAR;
        PG8_STAGE(PG8_SB(1, 0), cB + kstep, voffB); PG8_STAGE(PG8_SA(1, 0), cA + kstep, voffA); PG8_STAGE(PG8_SB(1, 1), cB + bhstep + kstep, voffB);
        PG8_WAIT_V(6); PG8_BAR;
    }
    for (;;) {
        const bool has_next = S.next(ui + 1, nxt);
        const char* nA = has_next ? (const char*)g.A + (size_t)nxt.pm * tstep : cA; const char* nB = has_next ? (const char*)g.Bt + (size_t)nxt.pn * tstep : cB;
        for (int t = 0; t < nt; t += 2) {
            const bool last = (t == nt - 2);
            const char* a1 = cA + (size_t)(t + 1) * kstep;
            const char* a2 = last ? nA : cA + (size_t)(t + 2) * kstep; const char* b2 = last ? nB : cB + (size_t)(t + 2) * kstep;
            const char* a3 = a2 + kstep; const char* b3 = b2 + kstep;
            if (last && has_next) S.a_ready(nxt);
            if constexpr (SP2) {
            PG8_LDB(B0, 0, 0); PG8_LDB(B1, 0, 1); PG8_SCHED; PG8_LDA(At, 0, 0); PG8_STAGE(PG8_SA(1, 1), a1 + hstep, voffA);
            PG8_WAIT_V(8); PG8_WAIT_L(0); PG8_BAR; PG8_MMA(0, 0, At, B0); PG8_MMA(0, 1, At, B1); PG8_BAR; PG8_SCHED;
            PG8_LDA(At, 0, 1); PG8_STAGE(PG8_SB(0, 0), b2, voffB); PG8_STAGE(PG8_SB(0, 1), b2 + bhstep, voffB); PG8_STAGE(PG8_SA(0, 0), a2, voffA);
            PG8_WAIT_V(8); PG8_WAIT_L(0); PG8_BAR; PG8_MMA(1, 0, At, B0); PG8_MMA(1, 1, At, B1); PG8_BAR; PG8_SCHED;
            PG8_LDB(B0, 1, 0); PG8_LDB(B1, 1, 1); PG8_SCHED; PG8_LDA(At, 1, 0); PG8_STAGE(PG8_SA(0, 1), a2 + hstep, voffA);
            PG8_WAIT_V(8); PG8_WAIT_L(0); PG8_BAR; PG8_MMA(0, 0, At, B0); PG8_MMA(0, 1, At, B1); PG8_BAR; PG8_SCHED;
            PG8_LDA(At, 1, 1); PG8_STAGE(PG8_SB(1, 0), b3, voffB); PG8_STAGE(PG8_SB(1, 1), b3 + bhstep, voffB); PG8_STAGE(PG8_SA(1, 0), a3, voffA);
            PG8_WAIT_V(8); PG8_WAIT_L(0); PG8_BAR; PG8_MMA(1, 0, At, B0); PG8_MMA(1, 1, At, B1); PG8_BAR; PG8_SCHED;
            } else {
            PG8_LDB(B0, 0, 0); PG8_SCHED; PG8_LDA(At, 0, 0); PG8_STAGE(PG8_SA(1, 1), a1 + hstep, voffA);
            PG8_WAIT_L(8); PG8_BAR; PG8_WAIT_L(0); PG8_MMA(0, 0, At, B0); PG8_BAR; PG8_SCHED;
            PG8_LDB(B1, 0, 1); PG8_STAGE(PG8_SB(0, 0), b2, voffB);
            PG8_BAR; PG8_WAIT_L(0); PG8_MMA(0, 1, At, B1); PG8_BAR;
            PG8_LDA(At, 0, 1); PG8_STAGE(PG8_SA(0, 0), a2, voffA);
            PG8_BAR; PG8_WAIT_L(0); PG8_MMA(1, 0, At, B0); PG8_BAR; PG8_SCHED;
            PG8_STAGE(PG8_SB(0, 1), b2 + bhstep, voffB);
            PG8_WAIT_V(6); PG8_BAR; PG8_MMA(1, 1, At, B1); PG8_BAR;
            PG8_LDB(B0, 1, 0); PG8_SCHED; PG8_LDA(At, 1, 0); PG8_STAGE(PG8_SA(0, 1), a2 + hstep, voffA);
            PG8_WAIT_L(8); PG8_BAR; PG8_WAIT_L(0); PG8_MMA(0, 0, At, B0); PG8_BAR; PG8_SCHED;
            PG8_LDB(B1, 1, 1); PG8_STAGE(PG8_SB(1, 0), b3, voffB);
            PG8_BAR; PG8_WAIT_L(0); PG8_MMA(0, 1, At, B1); PG8_BAR;
            PG8_LDA(At, 1, 1); PG8_STAGE(PG8_SA(1, 0), a3, voffA);
            PG8_BAR; PG8_WAIT_L(0); PG8_MMA(1, 0, At, B0); PG8_BAR; PG8_SCHED;
            PG8_STAGE(PG8_SB(1, 1), b3 + bhstep, voffB);
            PG8_WAIT_V(6); PG8_BAR; PG8_MMA(1, 1, At, B1); PG8_BAR;
            }
        }
        if constexpr (ALIGN_EPI) { if (wr == 0) PG8_BAR; }
        if constexpr (!Epi::AFTER_DRAIN) {
            E(acc, cur, wr, wc, fr, fq, ui);
            S.done(cur); }
        if (!has_next) break;
#pragma unroll
        for (int a = 0; a < 2; ++a)
#pragma unroll
            for (int b = 0; b < 2; ++b)
#pragma unroll
                for (int m = 0; m < 4; ++m)
#pragma unroll
                    for (int n = 0; n < 2; ++n) acc[a][b][m][n] = (f32x4){0.f, 0.f, 0.f, 0.f};
        cur = nxt; cA = nA; cB = nB; ++ui;
        if constexpr (ALIGN_EPI) { if (wr == 1) PG8_BAR; }
    }
    PG8_WAIT_V(0);
    if constexpr (!ALIGN_EPI) { if (wr == 0) PG8_BAR; }
    PG8_BAR;
    if constexpr (Epi::AFTER_DRAIN) { E.fused(acc, cur, wr, wc, fr, fq, lds, wid, lane); S.done(cur); }

#undef PG8_SA
#undef PG8_SB
#undef PG8_STAGE
#undef PG8_LDA
#undef PG8_LDB
#undef PG8_MMA
#undef PG8_WAIT_V
#undef PG8_WAIT_L
#undef PG8_BAR
#undef PG8_SCHED
}
}

constexpr int NWAVES = 8, NTHR = NWAVES * 64;
constexpr int SEQ = 8192, DM = 1024, MROWS = 2 * SEQ, NIN = 2432, ZP = 2560, FF = 4096, DEPTH = 4;
constexpr int C_QA = 0, C_KA = 384, C_VA = 512, C_QR = 640, C_KR = 1024, C_VR = 1408, C_GR = 1792, C_UP = 2176;
constexpr int Y_A = 0, Y_R = 384, Y_P = 768;
constexpr int NPHASE = 2 + 7 * DEPTH;

constexpr size_t MiB = 1u << 20;
constexpr size_t WS_CTL = 0, CTL_ZERO_BYTES = 64 * 1024;
constexpr size_t WS_SSQ = 1 * MiB;
constexpr size_t WS_W = 2 * MiB;
constexpr size_t W_LAYER = 23 * MiB, W_IN = 0, W_OUT = 5 * MiB, W_UP = 7 * MiB, W_DN = 15 * MiB;
constexpr size_t WS_XB = 94 * MiB;
constexpr size_t WS_H = 126 * MiB;
constexpr size_t WS_Z = 126 * MiB;
constexpr size_t WS_Y = 206 * MiB;
constexpr size_t WS_U = 238 * MiB;
constexpr size_t WS_ROPE = 254 * MiB;
constexpr size_t WS_END = 256 * MiB;
static_assert(WS_W + DEPTH * W_LAYER <= WS_XB && WS_Z + (size_t)MROWS * ZP * 2 <= WS_Y && WS_Y + (size_t)MROWS * DM * 2 <= WS_U && WS_U + 12 * MiB <= WS_H + 128 * MiB && WS_H + 128 * MiB <= WS_ROPE, "d_ws map");
constexpr size_t WS_BIAST = 128 * 1024;
constexpr size_t WS_PWT = 256 * 1024;
constexpr int CW_BAR = 4096;
constexpr int CW_GRP = 8192, CW_XID = 12288;

constexpr int RING_OFF = 0, RING_BYTES = 131072;
constexpr int MIX_BYTES = 143360;
constexpr int LDSCTL_OFF = MIX_BYTES, MISC_OFF = LDSCTL_OFF + 320;
constexpr int LDS_BYTES = 147456;

#define GAS __attribute__((address_space(1)))
#define LAS __attribute__((address_space(3)))
typedef unsigned short bf16;
typedef unsigned v4u __attribute__((ext_vector_type(4)));
typedef unsigned v2u __attribute__((ext_vector_type(2)));
typedef float f32x4 __attribute__((ext_vector_type(4)));
typedef GAS unsigned gu32;
#define LDS_WAIT() asm volatile("s_waitcnt lgkmcnt(0)" ::: "memory")
__device__ __forceinline__ unsigned f2bf(float f) { unsigned u = __builtin_bit_cast(unsigned, f); return (u + 0x7fffu + ((u >> 16) & 1u)) >> 16; }
__device__ __forceinline__ unsigned pk2(float lo, float hi) { return f2bf(lo) | (f2bf(hi) << 16); }
__device__ __forceinline__ float bflo(unsigned w) { return __uint_as_float(w << 16); }
__device__ __forceinline__ float bfhi(unsigned w) { return __uint_as_float(w & 0xffff0000u); }
__device__ __forceinline__ float bf1(const bf16* p) { return __uint_as_float((unsigned)(*p) << 16); }
__device__ __forceinline__ void ld8(const bf16* p, float (&o)[8]) { const v4u w = *(const v4u*)p; o[0] = bflo(w.x); o[1] = bfhi(w.x); o[2] = bflo(w.y); o[3] = bfhi(w.y); o[4] = bflo(w.z); o[5] = bfhi(w.z); o[6] = bflo(w.w); o[7] = bfhi(w.w); }
__device__ __forceinline__ void st8(bf16* p, const float (&o)[8]) { v4u w; w.x = pk2(o[0], o[1]); w.y = pk2(o[2], o[3]); w.z = pk2(o[4], o[5]); w.w = pk2(o[6], o[7]); *(v4u*)p = w; }
__device__ __forceinline__ float wave_sum(float v) {
#pragma unroll
    for (int o = 1; o < 64; o <<= 1) v += __shfl_xor(v, o);
    return v;
}
__device__ __constant__ unsigned char kT5[128] = {0,1,2,3,4,5,6,7,8,9,10,11,12,13,14,15,16,16,16,17,17,18,18,18,19,19,19,20,20,20,20,21,21,21,21,22,22,22,22,22,23,23,23,23,23,23,24,24,24,24,24,24,25,25,25,25,25,25,25,26,26,26,26,26,26,26,26,27,27,27,27,27,27,27,27,27,27,28,28,28,28,28,28,28,28,28,28,29,29,29,29,29,29,29,29,29,29,29,29,30,30,30,30,30,30,30,30,30,30,30,30,30,30,31,31,31,31,31,31,31,31,31,31,31,31,31,31,31};
__device__ __forceinline__ float ret_lg(int h) { return log1pf(-exp2f(-5.0f - (float)h)); }
#define XB_TMO      128
#define XB_XCNT(j)  (256  + 64 * (j))
#define XB_XSUB(j)  (1280 + 64 * (j))
#define XB_XGEN(j)  (2304 + 64 * (j))
#define XB_TOP      3328
#define XB_TOPGEN   3392
#define XCD_BAR_WORDS 3456
#define XB_SPIN_CAP (1u << 18)

__device__ __forceinline__ unsigned xb_ld(unsigned* p)              { return __hip_atomic_load(p, __ATOMIC_RELAXED, __HIP_MEMORY_SCOPE_AGENT); }
__device__ __forceinline__ unsigned xb_add(unsigned* p, unsigned v) { return __hip_atomic_fetch_add(p, v, __ATOMIC_RELAXED, __HIP_MEMORY_SCOPE_AGENT); }
__device__ __forceinline__ unsigned xb_xcc_id() { return (unsigned)__builtin_amdgcn_s_getreg((3 << 11) | 20) & 0xFu; }
#define XB_SPIN(cond, bar) do { unsigned _sp = 0; while (cond) { __builtin_amdgcn_s_sleep(1); \
    if ((++_sp & 255u) == 0u) { if (xb_ld(&(bar)[XB_TMO])) break; if (_sp > XB_SPIN_CAP) { atomicAdd(&(bar)[XB_TMO], 1u); break; } } } } while (0)

struct XcdBarrier {
    unsigned* bar; unsigned x;
    volatile LAS unsigned* st;
};

__device__ __forceinline__ XcdBarrier xcd_barrier_post(unsigned* bar, volatile LAS unsigned* st) {
    XcdBarrier b; b.bar = bar; b.x = xb_xcc_id(); b.st = st;
    if (threadIdx.x == 0) (void)xb_add(&bar[XB_XCNT(b.x)], 1u);
    return b;
}
__device__ __forceinline__ void xcd_barrier_complete(unsigned* bar, unsigned x, unsigned& nloc, unsigned& nx) {
    const unsigned G = gridDim.x * gridDim.y * gridDim.z;
    unsigned sum, cnt, mine, sp = 0u;
    for (;;) {
        sum = 0u; cnt = 0u; mine = 0u;
#pragma unroll
        for (unsigned j = 0; j < 16; ++j) { const unsigned c = xb_ld(&bar[XB_XCNT(j)]); sum += c; cnt += (c > 0u) ? 1u : 0u; mine = (j == x) ? c : mine; }
        if (sum == G) break;
        __builtin_amdgcn_s_sleep(1);
        if ((++sp & 255u) == 0u) { if (xb_ld(&bar[XB_TMO])) break; if (sp > XB_SPIN_CAP) { atomicAdd(&bar[XB_TMO], 1u); break; } }
    }
    nloc = mine > 0u ? mine : 1u; nx = cnt > 0u ? cnt : 1u;
}

__device__ __forceinline__ void xcd_barrier(const XcdBarrier& b) {
    asm volatile("s_waitcnt vmcnt(0)" ::: "memory");
    __syncthreads();
    if (threadIdx.x == 0) {
        unsigned* bar = b.bar;
        __builtin_amdgcn_s_waitcnt(0);
        unsigned nloc = b.st[0], nx = b.st[1];
        if (nloc == 0u) { xcd_barrier_complete(bar, b.x, nloc, nx); b.st[0] = nloc; b.st[1] = nx; }
        const unsigned old = xb_add(&bar[XB_XSUB(b.x)], 1u);
        const unsigned gen = old / nloc;
        if (old + 1u == (gen + 1u) * nloc) {
            __builtin_amdgcn_fence(__ATOMIC_RELEASE, "agent");
            asm volatile("s_waitcnt vmcnt(0)" ::: "memory");
            const unsigned og = xb_add(&bar[XB_TOP], 1u);
            const unsigned tg = og / nx;
            if (og + 1u == (tg + 1u) * nx) xb_add(&bar[XB_TOPGEN], 1u);
            else XB_SPIN(xb_ld(&bar[XB_TOPGEN]) == tg, bar);
            __builtin_amdgcn_fence(__ATOMIC_ACQUIRE, "agent");
            xb_add(&bar[XB_XGEN(b.x)], 1u);
            asm volatile("s_waitcnt vmcnt(0)" ::: "memory");
        } else {
            XB_SPIN(xb_ld(&bar[XB_XGEN(b.x)]) == gen, bar);
            __builtin_amdgcn_fence(__ATOMIC_ACQUIRE, "agent");
            asm volatile("s_waitcnt vmcnt(0)" ::: "memory");
        }
    }
    __syncthreads();
}

struct Args { const float* in[12]; float* out; unsigned char* ws; int ph_lo, ph_hi; };
struct Frame {
    LAS unsigned char* lds;
    int tid, lane, wave, G, bid;
    GAS unsigned char* ws;
};
__device__ __forceinline__ Frame phase_frame(const Frame& F0) { Frame F = F0; int t = threadIdx.x; asm volatile("" : "+v"(t)); F.tid = t; F.lane = t & 63; F.wave = __builtin_amdgcn_readfirstlane(t >> 6);
    unsigned long long w = (unsigned long long)F0.ws; asm volatile("" : "+s"(w)); F.ws = (GAS unsigned char*)w;
    return F; }
#define A_X        (A.in[0])
#define A_ATTN_G   (A.in[1])
#define A_W_IN     (A.in[2])
#define A_SINKS    (A.in[3])
#define A_RELB     (A.in[4])
#define A_POOLW    (A.in[5])
#define A_POOLS    (A.in[6])
#define A_W_OUT    (A.in[7])
#define A_MLP_G    (A.in[8])
#define A_W_UP     (A.in[9])
#define A_W_DOWN   (A.in[10])
#define A_FINAL_G  (A.in[11])
#define P_SSQ ((float*)(GAS float*)(F.ws + WS_SSQ))
#define P_XB ((bf16*)(GAS bf16*)(F.ws + WS_XB))
#define P_Z ((bf16*)(GAS bf16*)(F.ws + WS_Z))
#define P_Y ((bf16*)(GAS bf16*)(F.ws + WS_Y))
#define P_H ((bf16*)(GAS bf16*)(F.ws + WS_H))
#define P_U ((float*)(GAS float*)(F.ws + WS_U))
#define P_ROPE ((float*)(GAS float*)(F.ws + WS_ROPE))
#define P_BIAST ((float*)(GAS float*)(F.ws + WS_BIAST))
#define P_PWT ((bf16*)(GAS bf16*)(F.ws + WS_PWT))
__device__ __forceinline__ bf16* wptr(const Frame& F, int layer, size_t off) { return (bf16*)(GAS bf16*)(F.ws + WS_W + (size_t)layer * W_LAYER + off); }

#ifndef CONV_AHEAD
#define CONV_AHEAD 1
#endif
struct TItem { const float* W; bf16* WT; const float* gk; int K, N, k0, n0, colmode; };
__device__ __forceinline__ TItem p0_item(const Frame& F, const Args& A, int it) {
    constexpr int I_IN = (DM / 64) * (NIN / 32), I_OUT = (DM / 64) * (DM / 32), I_UP = (DM / 64) * (FF / 32), I_DN = (FF / 64) * (DM / 32), I_L = I_IN + I_OUT + I_UP + I_DN;
    const int l = it / I_L; int r = it % I_L; TItem t;
    if (r < I_IN) { t.W = A_W_IN + (size_t)l * DM * NIN; t.WT = wptr(F, l, W_IN); t.gk = A_ATTN_G + l * DM; t.K = DM; t.N = NIN; t.colmode = 1; }
    else if ((r -= I_IN) < I_OUT) { t.W = A_W_OUT + (size_t)l * DM * DM; t.WT = wptr(F, l, W_OUT); t.gk = nullptr; t.K = DM; t.N = DM; t.colmode = 0; }
    else if ((r -= I_OUT) < I_UP) { t.W = A_W_UP + (size_t)l * DM * FF; t.WT = wptr(F, l, W_UP); t.gk = A_MLP_G + l * DM; t.K = DM; t.N = FF; t.colmode = 0; }
    else { r -= I_UP; t.W = A_W_DOWN + (size_t)l * FF * DM; t.WT = wptr(F, l, W_DN); t.gk = nullptr; t.K = FF; t.N = DM; t.colmode = 0; }
    const int nblk = t.N / 32; t.k0 = 64 * (r / nblk); t.n0 = 32 * (r % nblk);
    return t;
}
__device__ __forceinline__ void p0_item_load(const TItem& t, int lane, float (&v)[32], f32x4 (&g)[2]) {
    const float* src = t.W + (size_t)(t.k0 + (lane >> 5)) * t.N + t.n0 + (lane & 31);
#pragma unroll
    for (int i = 0; i < 32; ++i) v[i] = src[(size_t)(2 * i) * t.N];
    if (t.gk) { const f32x4* gp = (const f32x4*)(t.gk + t.k0 + 8 * (lane & 7)); g[0] = gp[0]; g[1] = gp[1]; } else { g[0] = (f32x4){1.f, 1.f, 1.f, 1.f}; g[1] = g[0]; }
}
__device__ __forceinline__ void p0_item_store(const TItem& t, int lane, const float (&v)[32], const f32x4 (&g)[2], LAS float* scr) {
#pragma unroll
    for (int i = 0; i < 32; ++i) scr[(2 * i + (lane >> 5)) * 33 + (lane & 31)] = v[i];
    LDS_WAIT(); asm volatile("" ::: "memory");
    const int c = lane & 7;
#pragma unroll
    for (int j = 0; j < 4; ++j) { const int n = (lane >> 3) + 8 * j, ncol = t.n0 + n; const LAS float* s = scr + (8 * c) * 33 + n;
        const float cs = (t.colmode && (ncol < C_KA || (ncol >= C_KR && ncol < C_VR))) ? 0.125f : 1.0f;
        v4u o; o.x = pk2(s[0 * 33] * (g[0][0] * cs), s[1 * 33] * (g[0][1] * cs)); o.y = pk2(s[2 * 33] * (g[0][2] * cs), s[3 * 33] * (g[0][3] * cs));
        o.z = pk2(s[4 * 33] * (g[1][0] * cs), s[5 * 33] * (g[1][1] * cs)); o.w = pk2(s[6 * 33] * (g[1][2] * cs), s[7 * 33] * (g[1][3] * cs));
        *(GAS v4u*)(t.WT + (size_t)ncol * t.K + t.k0 + 8 * c) = o; }
    LDS_WAIT(); asm volatile("" ::: "memory");
}
__device__ __forceinline__ void convert_weights(const Frame& F, const Args& A, int l0, int l1, int gw, int NGW) {
    LAS float* scr = (LAS float*)(F.lds + RING_OFF + F.wave * 16384);
    constexpr int I_L = (DM / 64) * (NIN / 32) + (DM / 64) * (DM / 32) + (DM / 64) * (FF / 32) + (FF / 64) * (DM / 32);
    const int first = l0 * I_L, end = l1 * I_L;
    if (first + gw < end) {
        TItem cur = p0_item(F, A, first + gw); float va[32]; f32x4 ga[2]; p0_item_load(cur, F.lane, va, ga);
        for (int it = first + gw; it < end; it += NGW) {
            const bool more = it + NGW < end; TItem nxt = cur; float vb[32]; f32x4 gb[2];
            if (more) { nxt = p0_item(F, A, it + NGW); p0_item_load(nxt, F.lane, vb, gb); }
            p0_item_store(cur, F.lane, va, ga, scr);
            if (more) { cur = nxt;
#pragma unroll
                for (int i = 0; i < 32; ++i) va[i] = vb[i];
                ga[0] = gb[0]; ga[1] = gb[1]; }
        }
    }
    for (int it = gw; it < (l1 - l0) * (ZP - NIN); it += NGW) { const int l = l0 + it / (ZP - NIN), n = NIN + it % (ZP - NIN);
        GAS v4u* o = (GAS v4u*)(wptr(F, l, W_IN) + (size_t)n * DM) + F.lane; o[0] = (v4u){0u, 0u, 0u, 0u}; o[64] = (v4u){0u, 0u, 0u, 0u}; }
}
__device__ __forceinline__ void p0_prologue(const Frame& F0, const Args& A) {
    const Frame F = phase_frame(F0);
    const int gw = F.bid * NWAVES + F.wave, NGW = F.G * NWAVES;
    convert_weights(F, A, 0, CONV_AHEAD ? 1 : DEPTH, gw, NGW);
    for (int it = (F.bid * NTHR + F.tid); it < SEQ * 32; it += F.G * NTHR) { const int pos = it >> 5, i = it & 31;
        const float lin = (float)i * (1.0f / 31.0f); const float inv = 1.0f / powf(10000.0f, lin); const float ang = (float)pos * inv;
        const double a = (double)ang; const double k = rint(a * 0.15915494309189535); const float r = (float)(a - k * 6.283185307179586);
        P_ROPE[2 * it] = cosf(r); P_ROPE[2 * it + 1] = sinf(r); }
    for (int it = F.bid * NTHR + F.tid; it < 6 * 192; it += F.G * NTHR) { const int hq = it / 192, dist = it % 192 - 32;
        P_BIAST[it] = (dist >= 0 && dist < 128) ? A_RELB[(int)kT5[dist] * 6 + hq] : -1e30f; }
    for (int it = F.bid * NTHR + F.tid; it < DEPTH * 4 * 64 * 64; it += F.G * NTHR) { const int c = it & 63, d = (it >> 6) & 63, lg_ = it >> 12;
        P_PWT[it] = (bf16)f2bf(A_POOLW[((size_t)lg_ * 64 + c) * 64 + d] * A_POOLS[(lg_ >> 2) * 256 + (lg_ & 3) * 64 + d]); }
    for (int m = gw; m < MROWS; m += NGW) {
        const GAS f32x4* xr = (const GAS f32x4*)(A_X + (size_t)m * DM) + F.lane; f32x4 v[4]; float s = 0.f;
#pragma unroll
        for (int j = 0; j < 4; ++j) { v[j] = xr[64 * j]; s += (v[j].x * v[j].x + v[j].y * v[j].y) + (v[j].z * v[j].z + v[j].w * v[j].w); }
        s = wave_sum(s);
        GAS v2u* o8 = (GAS v2u*)(P_XB + (size_t)m * DM) + F.lane;
#pragma unroll
        for (int j = 0; j < 4; ++j) { v2u w; w.x = pk2(v[j].x, v[j].y); w.y = pk2(v[j].z, v[j].w); o8[64 * j] = w; }
        if (F.lane < 16) P_SSQ[(size_t)m * 16 + F.lane] = F.lane == 0 ? s : 0.f;
    }
}


typedef short bf16x8 __attribute__((ext_vector_type(8)));
typedef float f32x16 __attribute__((ext_vector_type(16)));
typedef float f32x2_t __attribute__((ext_vector_type(2))); typedef __bf16 bf16x2_t __attribute__((ext_vector_type(2)));
typedef short v4i16_t __attribute__((ext_vector_type(4)));
__device__ __forceinline__ unsigned cvtpk(float lo, float hi) { f32x2_t v = {lo, hi}; bf16x2_t b = __builtin_convertvector(v, bf16x2_t); return __builtin_bit_cast(unsigned, b); }
__device__ __forceinline__ int crow(int r, int hi) { return (r & 3) + 8 * (r >> 2) + 4 * hi; }
__device__ __forceinline__ bf16x8 pack8(const f32x16& p, int s) {
    v4u w; w.x = cvtpk(p[8 * s], p[8 * s + 1]); w.y = cvtpk(p[8 * s + 2], p[8 * s + 3]); w.z = cvtpk(p[8 * s + 4], p[8 * s + 5]); w.w = cvtpk(p[8 * s + 6], p[8 * s + 7]);
    return __builtin_bit_cast(bf16x8, w);
}
constexpr int KP = 72;
__device__ __forceinline__ v2u vtr(const LAS bf16* p) { return __builtin_bit_cast(v2u, __builtin_amdgcn_ds_read_tr16_b64_v4i16((LAS v4i16_t*)p)); }
__device__ __forceinline__ bf16x8 trfrag_perm(const LAS bf16* img, int kbase, int col0, int lane) {
    const LAS bf16* p = img + (kbase + 4 * (lane >> 5) + ((lane & 15) >> 2)) * KP + col0 + 16 * ((lane >> 4) & 1) + 4 * (lane & 3);
    const v2u lo = vtr(p), hi = vtr(p + 8 * KP); v4u w; w.x = lo.x; w.y = lo.y; w.z = hi.x; w.w = hi.y; return __builtin_bit_cast(bf16x8, w); }
__device__ __forceinline__ bf16x8 trfrag_nat(const LAS bf16* img, int kbase, int col0, int lane) {
    const LAS bf16* p = img + (kbase + 8 * (lane >> 5) + ((lane & 15) >> 2)) * KP + col0 + 16 * ((lane >> 4) & 1) + 4 * (lane & 3);
    const v2u lo = vtr(p), hi = vtr(p + 4 * KP); v4u w; w.x = lo.x; w.y = lo.y; w.z = hi.x; w.w = hi.y; return __builtin_bit_cast(bf16x8, w); }
__device__ __forceinline__ bf16x8 rowfrag(const LAS bf16* img, int row, int k0) { return *(const LAS bf16x8*)(img + row * KP + k0); }

__device__ __forceinline__ void store_row32(bf16* p, int hi, v2u w0, v2u w1, v2u w2, v2u w3) {
    { const auto rx = __builtin_amdgcn_permlane32_swap(w0.x, w1.x, false, false), ry = __builtin_amdgcn_permlane32_swap(w0.y, w1.y, false, false);
      v4u o; o.x = rx[0]; o.y = ry[0]; o.z = rx[1]; o.w = ry[1]; *(v4u*)(p + (hi ? 8 : 0)) = o; }
    { const auto rx = __builtin_amdgcn_permlane32_swap(w2.x, w3.x, false, false), ry = __builtin_amdgcn_permlane32_swap(w2.y, w3.y, false, false);
      v4u o; o.x = rx[0]; o.y = ry[0]; o.z = rx[1]; o.w = ry[1]; *(v4u*)(p + 16 + (hi ? 8 : 0)) = o; }
}

constexpr int M1_VS = 256 * KP * 2, M1_QS = 2 * M1_VS, M1_BT = M1_QS + 384 * KP * 2;
constexpr int PUP = 264;
constexpr int M1_UIMG = 128 * KP * 2;
static_assert(M1_BT + 3 * 192 * 4 <= MIX_BYTES && 6 * M1_UIMG <= MIX_BYTES, "mix1 LDS map");
__device__ __forceinline__ void mix1_fused(const Frame& F0, const Args& A, int layer) {
    const Frame F = phase_frame(F0);
    LAS bf16* KS = (LAS bf16*)(F.lds + RING_OFF);
    LAS bf16* VS = (LAS bf16*)(F.lds + RING_OFF + M1_VS);
    LAS bf16* QS = (LAS bf16*)(F.lds + RING_OFF + M1_QS);
    LAS float* BT = (LAS float*)(F.lds + RING_OFF + M1_BT);
    LAS bf16* UI = (LAS bf16*)(F.lds + RING_OFF);
    int tid_ = 0, lane = 0, l31 = 0, hi = 0;
#define OPAQUE_TID(k) do { int t_ = threadIdx.x; asm volatile("" : "+v"(t_)); tid_ = t_; lane = t_ & 63; l31 = t_ & 31; hi = (t_ >> 5) & 1; } while (0)
    const int vbid = (F.G % 8 == 0) ? (F.bid & 7) * (F.G >> 3) + (F.bid >> 3) : F.bid;
    for (int u = vbid; u < 256; u += F.G) {
        const int sel = u & 1, bn = u >> 1, b = bn >> 6, n = bn & 63;
        const int row0 = b * SEQ + n * 128;
        const int kt0 = (n == 0) ? 4 : 0;
        OPAQUE_TID(3);
        v4u kreg[4], vreg[4], qreg[6]; f32x2_t breg = {0.f, 0.f};
#pragma unroll
        for (int i = 0; i < 4; ++i) { const int item = tid_ + NTHR * i, key = item >> 3, c = item & 7; const bool ok = key >= kt0 * 32;
            const bf16* rp = P_Z + (size_t)(row0 - 128 + (ok ? key : 128)) * ZP + sel * 64 + 8 * c;
            kreg[i] = *(const v4u*)(rp + C_KA); vreg[i] = *(const v4u*)(rp + C_VA); }
#pragma unroll
        for (int i = 0; i < 6; ++i) { const int item = tid_ + NTHR * i, g = item >> 10, row = (item >> 3) & 127, c = item & 7;
            qreg[i] = *(const v4u*)(P_Z + (size_t)(row0 + row) * ZP + C_QA + (sel * 3 + g) * 64 + 8 * c); }
        if (tid_ < 288) breg = *(const f32x2_t*)(P_BIAST + sel * 576 + 2 * tid_);
        const float sk0 = A_SINKS[layer * 6 + sel * 3], sk1 = A_SINKS[layer * 6 + sel * 3 + 1], sk2 = A_SINKS[layer * 6 + sel * 3 + 2];
        OPAQUE_TID(1);
        {
            LAS bf16* PU = (LAS bf16*)(F.lds + RING_OFF);
            const int prow0 = row0 + 64 * sel - 15, t0 = (row0 + 64 * sel) & (SEQ - 1);
            v4u preg[5];
#pragma unroll
            for (int i = 0; i < 5; ++i) { const int item = tid_ + NTHR * i, r = item >> 5, c = item & 31; const bool ok = (item < 79 * 32) && (t0 - 15 + r >= 0);
                preg[i] = ok ? *(const v4u*)(P_Z + (size_t)(prow0 + r) * ZP + C_UP + 8 * c) : (v4u){0u, 0u, 0u, 0u}; }
            __syncthreads();
#pragma unroll
            for (int i = 0; i < 5; ++i) { const int item = tid_ + NTHR * i, r = item >> 5, c = item & 31; if (item < 79 * 32) *(LAS v4u*)(PU + r * PUP + 8 * c) = preg[i]; }
            __syncthreads();
            const int g = F.wave & 3, rt = F.wave >> 2, w = 2 << g;
            const int lrow = 15 + 32 * rt + l31, t = t0 + 32 * rt + l31;
            const float icnt = 1.0f / (float)(t + 1 < w ? t + 1 : w);
            f32x16 acc[2];
#pragma unroll
            for (int r = 0; r < 16; ++r) { acc[0][r] = 0.f; acc[1][r] = 0.f; }
#pragma unroll
            for (int ks = 0; ks < 4; ++ks) {
                const LAS bf16* up = PU + lrow * PUP + g * 64 + 16 * ks + 8 * hi;
                bf16x8 wf[2];
#pragma unroll
                for (int dh = 0; dh < 2; ++dh) wf[dh] = *(const bf16x8*)(P_PWT + ((size_t)(layer * 4 + g) * 64 + 32 * dh + l31) * 64 + 16 * ks + 8 * hi);
                float self[8], sum[8];
                { const v4u x = *(const LAS v4u*)up; self[0] = bflo(x.x); self[1] = bfhi(x.x); self[2] = bflo(x.y); self[3] = bfhi(x.y); self[4] = bflo(x.z); self[5] = bfhi(x.z); self[6] = bflo(x.w); self[7] = bfhi(x.w); }
#pragma unroll
                for (int e = 0; e < 8; ++e) sum[e] = 0.f;
                for (int k = 0; k < w; k += 2) { const v4u x = *(const LAS v4u*)(up - k * PUP), y2 = *(const LAS v4u*)(up - (k + 1) * PUP);
                    sum[0] += bflo(x.x) + bflo(y2.x); sum[1] += bfhi(x.x) + bfhi(y2.x); sum[2] += bflo(x.y) + bflo(y2.y); sum[3] += bfhi(x.y) + bfhi(y2.y);
                    sum[4] += bflo(x.z) + bflo(y2.z); sum[5] += bfhi(x.z) + bfhi(y2.z); sum[6] += bflo(x.w) + bflo(y2.w); sum[7] += bfhi(x.w) + bfhi(y2.w); }
                v4u pw_; pw_.x = cvtpk(sum[0] * icnt - self[0], sum[1] * icnt - self[1]); pw_.y = cvtpk(sum[2] * icnt - self[2], sum[3] * icnt - self[3]);
                pw_.z = cvtpk(sum[4] * icnt - self[4], sum[5] * icnt - self[5]); pw_.w = cvtpk(sum[6] * icnt - self[6], sum[7] * icnt - self[7]);
                const bf16x8 pf = __builtin_bit_cast(bf16x8, pw_);
#pragma unroll
                for (int dh = 0; dh < 2; ++dh) acc[dh] = __builtin_amdgcn_mfma_f32_32x32x16_bf16(wf[dh], pf, acc[dh], 0, 0, 0);
            }
            bf16* yp = P_Y + (size_t)(row0 + 64 * sel + 32 * rt + l31) * DM + Y_P + g * 64;
#pragma unroll
            for (int dh = 0; dh < 2; ++dh) { v2u o[4];
#pragma unroll
                for (int a = 0; a < 4; ++a) { o[a].x = cvtpk(acc[dh][4 * a], acc[dh][4 * a + 1]); o[a].y = cvtpk(acc[dh][4 * a + 2], acc[dh][4 * a + 3]); }
                store_row32(yp + 32 * dh, hi, o[0], o[1], o[2], o[3]); }
        }
        OPAQUE_TID(5);
        __syncthreads();
#pragma unroll
        for (int i = 0; i < 4; ++i) { const int item = tid_ + NTHR * i, key = item >> 3, c = item & 7; *(LAS v4u*)(KS + key * KP + 8 * c) = kreg[i]; *(LAS v4u*)(VS + key * KP + 8 * c) = vreg[i]; }
#pragma unroll
        for (int i = 0; i < 6; ++i) { const int item = tid_ + NTHR * i, g = item >> 10, row = (item >> 3) & 127, c = item & 7; *(LAS v4u*)(QS + (g * 128 + row) * KP + 8 * c) = qreg[i]; }
        if (tid_ < 288) *(LAS f32x2_t*)(BT + 2 * tid_) = breg;
        __syncthreads();
        OPAQUE_TID(6);
        for (int task = F.wave; task < 12; task += 8) {
            const int g = task >> 2, qb = task & 3, hq = sel * 3 + g;
            bf16x8 qf[4];
#pragma unroll
            for (int ks = 0; ks < 4; ++ks) qf[ks] = rowfrag(QS, g * 128 + 32 * qb + l31, 16 * ks + 8 * hi);
            f32x16 S[5];
#pragma unroll
            for (int kk = 0; kk < 5; ++kk) {
#pragma unroll
                for (int r = 0; r < 16; ++r) S[kk][r] = 0.f;
#pragma unroll
                for (int ks = 0; ks < 4; ++ks) S[kk] = __builtin_amdgcn_mfma_f32_32x32x16_bf16(rowfrag(KS, 32 * (qb + kk) + l31, 16 * ks + 8 * hi), qf[ks], S[kk], 0, 0, 0);
            }
#pragma unroll
            for (int kk = 0; kk < 5; ++kk) {
                const LAS float* bt = BT + g * 192 + 160 + l31 - 4 * hi - 32 * kk;
                float bv[16];
#pragma unroll
                for (int r = 0; r < 16; ++r) bv[r] = bt[-((r & 3) + 8 * (r >> 2))];
#pragma unroll
                for (int r = 0; r < 16; ++r) S[kk][r] += bv[r];
            }
            if (n == 0) {
#pragma unroll
                for (int kk = 0; kk < 5; ++kk)
#pragma unroll
                    for (int r = 0; r < 16; ++r) if (128 - crow(r, hi) - 32 * kk > 32 * qb) S[kk][r] = -1e30f;
            }
            float mx = -1e30f;
#pragma unroll
            for (int kk = 0; kk < 5; ++kk)
#pragma unroll
                for (int r = 0; r < 16; ++r) mx = fmaxf(mx, S[kk][r]);
            mx = fmaxf(mx, __shfl_xor(mx, 32));
            const float sk = g == 0 ? sk0 : (g == 1 ? sk1 : sk2); mx = fmaxf(mx, sk);
            float lsum = 0.f;
#pragma unroll
            for (int kk = 0; kk < 5; ++kk)
#pragma unroll
                for (int r = 0; r < 16; ++r) { const float p = __expf(S[kk][r] - mx); S[kk][r] = p; lsum += p; }
            lsum += __shfl_xor(lsum, 32); lsum += __expf(sk - mx);
            f32x16 O[2];
#pragma unroll
            for (int r = 0; r < 16; ++r) { O[0][r] = 0.f; O[1][r] = 0.f; }
#pragma unroll
            for (int kk = 0; kk < 5; ++kk)
#pragma unroll
                for (int s2 = 0; s2 < 2; ++s2) { const bf16x8 pf = pack8(S[kk], s2);
#pragma unroll
                    for (int dh = 0; dh < 2; ++dh) O[dh] = __builtin_amdgcn_mfma_f32_32x32x16_bf16(trfrag_perm(VS, 32 * (qb + kk) + 16 * s2, 32 * dh, lane), pf, O[dh], 0, 0, 0); }
            const float inv = __builtin_amdgcn_rcpf(lsum);
            bf16* yp = P_Y + (size_t)(row0 + 32 * qb + l31) * DM + Y_A + hq * 64;
#pragma unroll
            for (int dh = 0; dh < 2; ++dh) { v2u o[4];
#pragma unroll
                for (int a = 0; a < 4; ++a) { o[a].x = cvtpk(O[dh][4 * a] * inv, O[dh][4 * a + 1] * inv); o[a].y = cvtpk(O[dh][4 * a + 2] * inv, O[dh][4 * a + 3] * inv); }
                store_row32(yp + 32 * dh, hi, o[0], o[1], o[2], o[3]); }
        }
        OPAQUE_TID(0);
        v4u ureg[12];
#pragma unroll
        for (int i = 0; i < 12; ++i) { const int item = tid_ + NTHR * i, img = item >> 10, key = (item >> 3) & 127, c = item & 7;
            ureg[i] = *(const v4u*)(P_Z + (size_t)(row0 + key) * ZP + ((img & 1) ? C_VR : C_KR) + (3 * sel + (img >> 1)) * 64 + 8 * c); }
        OPAQUE_TID(2);
        __syncthreads();
#pragma unroll
        for (int i = 0; i < 12; ++i) { const int item = tid_ + NTHR * i, img = item >> 10, key = (item >> 3) & 127, c = item & 7; v4u w = ureg[i];
            if (img & 1) { const float zeta = __expf(ret_lg(3 * sel + (img >> 1)) * (float)(127 - key));
                w.x = cvtpk(bflo(w.x) * zeta, bfhi(w.x) * zeta); w.y = cvtpk(bflo(w.y) * zeta, bfhi(w.y) * zeta); w.z = cvtpk(bflo(w.z) * zeta, bfhi(w.z) * zeta); w.w = cvtpk(bflo(w.w) * zeta, bfhi(w.w) * zeta); }
            *(LAS v4u*)(UI + img * (128 * KP) + key * KP + 8 * c) = w; }
        __syncthreads();
        OPAQUE_TID(4);
        for (int task = F.wave; task < 12; task += 8) {
            const int hh = task >> 2, et = (task >> 1) & 1, dt = task & 1, h = 3 * sel + hh;
            const LAS bf16* kimg = UI + (2 * hh) * (128 * KP); const LAS bf16* vimg = UI + (2 * hh + 1) * (128 * KP);
            f32x16 acc;
#pragma unroll
            for (int r = 0; r < 16; ++r) acc[r] = 0.f;
#pragma unroll
            for (int ks = 0; ks < 8; ++ks) acc = __builtin_amdgcn_mfma_f32_32x32x16_bf16(trfrag_nat(vimg, 16 * ks, 32 * et, lane), trfrag_nat(kimg, 16 * ks, 32 * dt, lane), acc, 0, 0, 0);
            float* o = P_U + ((size_t)(b * 6 + h) * 64 + n) * 4096 + (32 * et) * 64 + 32 * dt + l31;
#pragma unroll
            for (int r = 0; r < 16; ++r) o[crow(r, hi) * 64] = acc[r];
        }
    }
}
#undef OPAQUE_TID

__device__ __forceinline__ void mix_scan_pair(const Frame& F0, const Args& A) {
    const Frame F = phase_frame(F0);
    const int NW_ = 12 * 4096 / 32;
    for (int wi = F.bid * NWAVES + F.wave; wi < NW_; wi += F.G * NWAVES) {
        const int chain = wi * 32 + (F.lane & 31), half = F.lane >> 5, bh = chain >> 12, de = chain & 4095, h = bh % 6;
        const float gch = __expf(ret_lg(h) * 128.0f);
        float* p = P_U + ((size_t)bh * 64 + 32 * half) * 4096 + de;
        float v[32];
#pragma unroll
        for (int k = 0; k < 32; ++k) v[k] = p[(size_t)k * 4096];
        float R = 0.f;
#pragma unroll
        for (int k = 0; k < 32; ++k) { const float u = v[k]; v[k] = R; R = R * gch + u; }
        const float carry = __shfl_xor(R, 32);
        float cf = half ? 1.0f : 0.0f;
#pragma unroll
        for (int k = 0; k < 32; ++k) { p[(size_t)k * 4096] = v[k] + cf * carry; cf *= gch; }
    }
}

constexpr int R3_VS = 384 * KP * 2, R3_RS = 2 * R3_VS, R3_DT = R3_RS + 192 * KP * 2;
static_assert(R3_DT + 3 * 160 * 4 <= MIX_BYTES, "retention-out LDS map");
__device__ __forceinline__ void mix_retout3(const Frame& F0, const Args& A) {
    const Frame F = phase_frame(F0);
    const int lane = F.lane, l31 = lane & 31, hi = lane >> 5;
    LAS bf16* KS = (LAS bf16*)(F.lds + RING_OFF);
    LAS bf16* VS = (LAS bf16*)(F.lds + RING_OFF + R3_VS);
    LAS bf16* RS = (LAS bf16*)(F.lds + RING_OFF + R3_RS);
    LAS float* DT = (LAS float*)(F.lds + RING_OFF + R3_DT);
    const int w = F.wave;
    const int nt = (w < 3 || w == 7) ? 1 : 2;
    const int th0 = w < 3 ? w : (w < 6 ? w - 3 : (w == 6 ? 0 : 2)), tq0 = w < 3 ? 3 : (w < 6 ? 2 : 1);
    const int th1 = w < 6 ? w - 3 : 1, tq1 = w < 6 ? 0 : 1;
    const int vbid = (F.G % 8 == 0) ? (F.bid & 7) * (F.G >> 3) + (F.bid >> 3) : F.bid;
    for (int u = vbid; u < 256; u += F.G) {
        const int hp = u & 1, bn = u >> 1, b = bn >> 6, n = bn & 63, row0 = b * SEQ + n * 128;
        v4u kreg[6], vreg[6]; f32x4 rreg[6]; bf16x8 qf[2][4]; v2u greg[2][8];
#pragma unroll
        for (int i = 0; i < 6; ++i) { const int item = F.tid + NTHR * i, hh = item >> 10, key = (item >> 3) & 127, c = item & 7;
            const bf16* rp = P_Z + (size_t)(row0 + key) * ZP + (3 * hp + hh) * 64 + 8 * c;
            kreg[i] = *(const v4u*)(rp + C_KR); vreg[i] = *(const v4u*)(rp + C_VR); }
#pragma unroll
        for (int i = 0; i < 6; ++i) { const int item = F.tid + NTHR * i, hh = item >> 10, e = (item >> 4) & 63, d4 = item & 15;
            rreg[i] = *(const f32x4*)(P_U + ((size_t)(b * 6 + 3 * hp + hh) * 64 + n) * 4096 + e * 64 + 4 * d4); }
#pragma unroll
        for (int ti = 0; ti < 2; ++ti) { const int th = ti ? th1 : th0, tq = ti ? tq1 : tq0, h = 3 * hp + th, rowq = row0 + 32 * tq + l31;
            if (ti < nt) {
                const bf16* qp = P_Z + (size_t)rowq * ZP + C_QR + h * 64 + 8 * hi;
#pragma unroll
                for (int ks = 0; ks < 4; ++ks) qf[ti][ks] = *(const bf16x8*)(qp + 16 * ks);
                const bf16* gp = P_Z + (size_t)rowq * ZP + C_GR + h * 64 + 4 * hi;
#pragma unroll
                for (int j = 0; j < 8; ++j) greg[ti][j] = *(const v2u*)(gp + 32 * (j >> 2) + 8 * (j & 3));
            } }
        __syncthreads();
#pragma unroll
        for (int i = 0; i < 6; ++i) { const int item = F.tid + NTHR * i, hh = item >> 10, key = (item >> 3) & 127, c = item & 7;
            *(LAS v4u*)(KS + (hh * 128 + key) * KP + 8 * c) = kreg[i]; *(LAS v4u*)(VS + (hh * 128 + key) * KP + 8 * c) = vreg[i]; }
#pragma unroll
        for (int i = 0; i < 6; ++i) { const int item = F.tid + NTHR * i, hh = item >> 10, e = (item >> 4) & 63, d4 = item & 15;
            v2u w2; w2.x = cvtpk(rreg[i][0], rreg[i][1]); w2.y = cvtpk(rreg[i][2], rreg[i][3]); *(LAS v2u*)(RS + (hh * 64 + e) * KP + 4 * d4) = w2; }
        { const float lg0 = ret_lg(3 * hp), lg1 = ret_lg(3 * hp + 1), lg2 = ret_lg(3 * hp + 2);
          for (int e = F.tid; e < 3 * 160; e += NTHR) { const int hh = e / 160, diff = e % 160 - 32; const float lgv = hh == 0 ? lg0 : (hh == 1 ? lg1 : lg2); DT[e] = diff >= 0 ? __expf(lgv * (float)diff) : 0.f; } }
        __syncthreads();
#pragma unroll
        for (int ti = 0; ti < 2; ++ti) {
            if (ti < nt) {
                const int hh = ti ? th1 : th0, qb = ti ? tq1 : tq0, h = 3 * hp + hh, rowq = row0 + 32 * qb + l31; const float lg = ret_lg(h);
                f32x16 O[2], C[2];
#pragma unroll
                for (int r = 0; r < 16; ++r) { O[0][r] = 0.f; O[1][r] = 0.f; C[0][r] = 0.f; C[1][r] = 0.f; }
#pragma unroll
                for (int eh = 0; eh < 2; ++eh)
#pragma unroll
                    for (int ks = 0; ks < 4; ++ks) C[eh] = __builtin_amdgcn_mfma_f32_32x32x16_bf16(rowfrag(RS, hh * 64 + 32 * eh + l31, 16 * ks + 8 * hi), qf[ti][ks], C[eh], 0, 0, 0);
                for (int kt = 0; kt <= qb; ++kt) {
                    f32x16 S;
#pragma unroll
                    for (int r = 0; r < 16; ++r) S[r] = 0.f;
#pragma unroll
                    for (int ks = 0; ks < 4; ++ks) S = __builtin_amdgcn_mfma_f32_32x32x16_bf16(rowfrag(KS, hh * 128 + 32 * kt + l31, 16 * ks + 8 * hi), qf[ti][ks], S, 0, 0, 0);
                    const int dbase = 32 * (qb - kt) + l31 + 32;
#pragma unroll
                    for (int r = 0; r < 16; ++r) S[r] *= DT[hh * 160 + dbase - crow(r, hi)];
#pragma unroll
                    for (int s2 = 0; s2 < 2; ++s2) { const bf16x8 pf = pack8(S, s2);
#pragma unroll
                        for (int eh = 0; eh < 2; ++eh) O[eh] = __builtin_amdgcn_mfma_f32_32x32x16_bf16(trfrag_perm(VS + hh * (128 * KP), 32 * kt + 16 * s2, 32 * eh, lane), pf, O[eh], 0, 0, 0); }
                }
                const float xi = __expf(lg * (float)(32 * qb + l31 + 1));
                float ms = 0.f;
#pragma unroll
                for (int eh = 0; eh < 2; ++eh)
#pragma unroll
                    for (int r = 0; r < 16; ++r) { const float o = O[eh][r] + xi * C[eh][r]; O[eh][r] = o; ms += o * o; }
                ms += __shfl_xor(ms, 32);
                const float rn = __builtin_amdgcn_rsqf(ms * (1.0f / 64.0f) + 1e-6f);
                bf16* yp = P_Y + (size_t)rowq * DM + Y_R + h * 64;
#pragma unroll
                for (int eh = 0; eh < 2; ++eh) { v2u o[4];
#pragma unroll
                    for (int a = 0; a < 4; ++a) { const v2u gw = greg[ti][eh * 4 + a];
                        const float g0 = bflo(gw.x), g1 = bfhi(gw.x), g2 = bflo(gw.y), g3 = bfhi(gw.y);
                        const float o0 = g0 * __builtin_amdgcn_rcpf(1.0f + __expf(-g0)) * O[eh][4 * a] * rn, o1 = g1 * __builtin_amdgcn_rcpf(1.0f + __expf(-g1)) * O[eh][4 * a + 1] * rn;
                        const float o2 = g2 * __builtin_amdgcn_rcpf(1.0f + __expf(-g2)) * O[eh][4 * a + 2] * rn, o3 = g3 * __builtin_amdgcn_rcpf(1.0f + __expf(-g3)) * O[eh][4 * a + 3] * rn;
                        o[a].x = cvtpk(o0, o1); o[a].y = cvtpk(o2, o3); }
                    store_row32(yp + 32 * eh, hi, o[0], o[1], o[2], o[3]); }
            }
        }
    }
}
__device__ __forceinline__ void final_norm(const Frame& F0, const Args& A) {
    const Frame F = phase_frame(F0);
    const int gw = F.bid * NWAVES + F.wave, NGW = F.G * NWAVES;
    for (int m = gw; m < MROWS; m += NGW) {
        const GAS v4u* xr = (const GAS v4u*)(P_XB + (size_t)m * DM) + F.lane; float v[16]; float s = 0.f;
#pragma unroll
        for (int j = 0; j < 2; ++j) { const v4u w = xr[64 * j];
            v[8 * j] = bflo(w.x); v[8 * j + 1] = bfhi(w.x); v[8 * j + 2] = bflo(w.y); v[8 * j + 3] = bfhi(w.y); v[8 * j + 4] = bflo(w.z); v[8 * j + 5] = bfhi(w.z); v[8 * j + 6] = bflo(w.w); v[8 * j + 7] = bfhi(w.w); }
#pragma unroll
        for (int e = 0; e < 16; ++e) s += v[e] * v[e];
        const float rs = 1.0f / sqrtf(wave_sum(s) * (1.0f / DM) + 1e-6f);
        GAS f32x4* o = (GAS f32x4*)(A.out + (size_t)m * DM);
#pragma unroll
        for (int j = 0; j < 2; ++j) { const int c0 = 512 * j + 8 * F.lane; const f32x4 g0 = *(const GAS f32x4*)(A_FINAL_G + c0), g1 = *(const GAS f32x4*)(A_FINAL_G + c0 + 4);
            o[c0 / 4] = (f32x4){v[8 * j] * rs * g0.x, v[8 * j + 1] * rs * g0.y, v[8 * j + 2] * rs * g0.z, v[8 * j + 3] * rs * g0.w};
            o[c0 / 4 + 1] = (f32x4){v[8 * j + 4] * rs * g1.x, v[8 * j + 5] * rs * g1.y, v[8 * j + 6] * rs * g1.z, v[8 * j + 7] * rs * g1.w}; }
    }
}

__device__ __forceinline__ void group_handoff(const XcdBarrier& b, unsigned* cnt, unsigned target, bool same_xcd) {
    asm volatile("s_waitcnt vmcnt(0)" ::: "memory");
    __syncthreads();
    if (threadIdx.x == 0) {
        __builtin_amdgcn_s_waitcnt(0);
        if (!same_xcd) { __builtin_amdgcn_fence(__ATOMIC_RELEASE, "agent"); asm volatile("s_waitcnt vmcnt(0)" ::: "memory"); }
        (void)xb_add(cnt, 1u);
        XB_SPIN(xb_ld(cnt) < target, b.bar);
        __builtin_amdgcn_fence(__ATOMIC_ACQUIRE, "agent");
        asm volatile("s_waitcnt vmcnt(0)" ::: "memory");
    }
    __syncthreads();
}

__global__ void __launch_bounds__(NTHR, 2) mk_fwd(Args args) {
    extern __shared__ __attribute__((aligned(16))) unsigned char lds[];
    const Args& A = args;
    Frame F;
    F.lds = (LAS unsigned char*)lds;
    F.tid = threadIdx.x; F.lane = F.tid & 63; F.wave = __builtin_amdgcn_readfirstlane(F.tid >> 6); F.G = gridDim.x; F.bid = blockIdx.x; F.ws = (GAS unsigned char*)args.ws;
    for (int u = F.tid; u < (LDS_BYTES - LDSCTL_OFF) / 4; u += NTHR) ((LAS unsigned*)(F.lds + LDSCTL_OFF))[u] = 0u;
    __syncthreads();
    const int lo = args.ph_lo, hi = args.ph_hi;
    XcdBarrier bar; bar.bar = (unsigned*)(F.ws + WS_CTL) + CW_BAR; bar.x = 0; bar.st = nullptr;
    if (hi - lo > 1) bar = xcd_barrier_post((unsigned*)(F.ws + WS_CTL) + CW_BAR, (volatile LAS unsigned*)(F.lds + MISC_OFF) + 8);

    const int vc = (F.G % 8 == 0) ? (F.bid & 7) * (F.G >> 3) + (F.bid >> 3) : F.bid;
    const bool grp_ok = lo == 0 && hi == NPHASE && (F.G & 3) == 0 && (64 % (F.G >> 2)) == 0;
    unsigned* const ctlw = (unsigned*)(F.ws + WS_CTL);
    if (grp_ok && F.tid == 0) (void)xb_add(ctlw + CW_XID + vc, 1u + bar.x);
    if (lo == 0) { p0_prologue(F, A); if (hi > 1) xcd_barrier(bar); }
    bool grp_same = false; unsigned grp_n = 0;
    if (grp_ok) { grp_same = true;
#pragma unroll
        for (int j = 0; j < 4; ++j) grp_same = grp_same && (xb_ld(ctlw + CW_XID + (vc & ~3) + j) == 1u + bar.x); }
    for (int ph = (lo == 0 ? 1 : lo); ph < hi; ++ph) {
        if (ph == NPHASE - 1) break;
        if (ph != 0 && ph != NPHASE - 1) {
            const int layer = (ph - 1) / 7, s = (ph - 1) % 7;
            if (s == 0) {
                pg8::Gemm g{P_XB, wptr(F, layer, W_IN), MROWS, ZP, DM}; pg8::PanelOrder S; S.init(MROWS, ZP, F.G, F.bid);
                LAS float* rtab = (LAS float*)(F.lds + RING_BYTES);
                pg8::EpiIn E{P_Z, ZP, rtab, P_ROPE, P_SSQ};
                pg8::gemm_phase<pg8::EpiIn, pg8::PanelOrder, true, true>(F.lds + RING_OFF, g, S, E);
                if (CONV_AHEAD && layer + 1 < DEPTH) {
                    const int nwg = (MROWS / 256) * (ZP / 256), nmax = (nwg + F.G - 1) / F.G; pg8::Unit ul; const bool busy = S.next(nmax - 1, ul);
                    const int nlast = (ZP / 256) - 4 * (nmax - 1);
                    if ((F.G & 3) == 0 && nlast > 0 && nlast < 4) { if (!busy) { __syncthreads(); const Frame Fc = phase_frame(F); const int nid = 4 - nlast;
                            convert_weights(Fc, A, layer + 1, layer + 2, ((S.vc >> 2) * nid + (S.vc & 3) - nlast) * NWAVES + Fc.wave, (F.G >> 2) * nid * NWAVES); } }
                    else { __syncthreads(); const Frame Fc = phase_frame(F); convert_weights(Fc, A, layer + 1, layer + 2, F.bid * NWAVES + Fc.wave, F.G * NWAVES); }
                }
            } else if (s == 1) {
                mix1_fused(F, A, layer);
            } else if (s == 2) {
                mix_scan_pair(F, A);
            } else if (s == 3) {
                mix_retout3(F, A);
            } else if (s == 4 || s == 6) {
                const bool dn = (s == 6);
                pg8::Gemm g{dn ? P_H : P_Y, wptr(F, layer, dn ? W_DN : W_OUT), MROWS, DM, dn ? FF : DM}; pg8::PanelOrder S; S.init(MROWS, DM, F.G, F.bid);
                pg8::EpiRes E{P_XB, P_SSQ};
                pg8::gemm_phase<pg8::EpiRes, pg8::PanelOrder, true, true>(F.lds + RING_OFF, g, S, E);
            } else {
                pg8::Gemm g{P_XB, wptr(F, layer, W_UP), MROWS, FF, DM}; pg8::PanelOrder S; S.init(MROWS, FF, F.G, F.bid);
                LAS float* rtab = (LAS float*)(F.lds + RING_BYTES);
                pg8::EpiUp E{P_H, FF, rtab, P_SSQ};
                pg8::gemm_phase<pg8::EpiUp, pg8::PanelOrder, true, true>(F.lds + RING_OFF, g, S, E);
            }
        }
        if (ph + 1 < hi) {
            const int s = (ph - 1) % 7;
            if (grp_ok && (s == 3 || s == 5)) { ++grp_n; group_handoff(bar, ctlw + CW_GRP + 32 * (vc >> 2), 4u * grp_n, grp_same); }
            else xcd_barrier(bar);
        }
    }
    if (hi == NPHASE) final_norm(F, A);
}

#ifndef MK_ONE_LAUNCH
#define MK_ONE_LAUNCH 1
#endif
extern "C" void kernel_launch(void* const* d_in, const int* in_sizes, int n_in, void* d_out, int out_size, void* d_ws, size_t ws_size, hipStream_t stream) {
    static int grid = 0;
    if (grid == 0) {
        if (n_in != 12 || in_sizes[0] != MROWS * DM || out_size != MROWS * DM || ws_size < WS_END) { fprintf(stderr, "kernel_launch: unexpected shapes (n_in %d, in0 %d, out %d, ws %zu); nothing launched\n", n_in, n_in > 0 ? in_sizes[0] : -1, out_size, ws_size); grid = -1; return; }
        int dev = 0, cus = 0, per_cu = 0;
        if (hipGetDevice(&dev) != hipSuccess || hipDeviceGetAttribute(&cus, hipDeviceAttributeMultiprocessorCount, dev) != hipSuccess) { grid = -1; return; }
        if (hipFuncSetAttribute((const void*)mk_fwd, hipFuncAttributeMaxDynamicSharedMemorySize, LDS_BYTES) != hipSuccess) { fprintf(stderr, "kernel_launch: hipFuncSetAttribute failed\n"); grid = -1; return; }
        if (hipOccupancyMaxActiveBlocksPerMultiprocessor(&per_cu, (const void*)mk_fwd, NTHR, LDS_BYTES) != hipSuccess || per_cu < 1) { fprintf(stderr, "kernel_launch: occupancy query says %d blocks per CU\n", per_cu); per_cu = 1; }
        (void)hipGetLastError();
        grid = cus;
    }
    if (grid < 0) return;
    (void)hipMemsetAsync((char*)d_ws + WS_CTL, 0, CTL_ZERO_BYTES, stream);
    Args a{};
    for (int i = 0; i < 12; ++i) a.in[i] = (const float*)d_in[i];
    a.out = (float*)d_out; a.ws = (unsigned char*)d_ws;
#if MK_ONE_LAUNCH
    a.ph_lo = 0; a.ph_hi = NPHASE;
    hipLaunchKernelGGL(mk_fwd, dim3(grid), dim3(NTHR), LDS_BYTES, stream, a);
#else
    for (int ph = 0; ph < NPHASE; ++ph) { a.ph_lo = ph; a.ph_hi = ph + 1; hipLaunchKernelGGL(mk_fwd, dim3(grid), dim3(NTHR), LDS_BYTES, stream, a); }
#endif
}
```
